# Optimizing an MI355X kernel written in HIP

```python
import jax, jax.numpy as jnp
from jax import lax
import numpy as np

D_MODEL = 2048
BATCH = 4
SEQ = 4096
DEPTH = 4
DEC_BATCH = 4
DEC_SEQ = 8192
PAST_LEN = 128

HEAD_DIM = 128
DILATIONS = ((128, 1), (512, 4), (2048, 16))
A_HEADS_PER_GROUP = 4
A_HEADS = A_HEADS_PER_GROUP * len(DILATIONS)
B_Q_HEADS = D_MODEL // 256
B_KV_HEADS = 2
B_HALF_WINDOW = 128
B_BLOCK = 128
C_HEADS = D_MODEL // HEAD_DIM
GRID_W = 64
NA_ROWS = 8
NA_COLS = 16
NUM_BUCKETS = 32
MAX_DISTANCE = 1024
D_FF = -(-8 * D_MODEL // 768) * 256
RMS_EPS = 1e-6
A_IN = len(DILATIONS) * 3 * A_HEADS_PER_GROUP * HEAD_DIM
B_IN = (B_Q_HEADS + 2 * B_KV_HEADS) * HEAD_DIM
AB_IN = A_IN + B_IN
AB_OUT = (A_HEADS_PER_GROUP + B_Q_HEADS) * HEAD_DIM
C_IN = 3 * C_HEADS * HEAD_DIM
C_OUT = C_HEADS * HEAD_DIM
SCALE = HEAD_DIM ** -0.5
NEG_INF = -1e30

kernel_name = "hybrid_dilated_window_neighbourhood_encoder"


def rms_norm(x, g):
    xf = x.astype(jnp.float32)
    y = xf * lax.rsqrt(jnp.mean(xf * xf, axis=-1, keepdims=True) + RMS_EPS)
    return (y * g.astype(jnp.float32)).astype(x.dtype)


def t5_bucket(rel):
    nb = NUM_BUCKETS // 2
    max_exact = nb // 2
    ret = (rel > 0).astype(np.int32) * nb
    n = np.abs(rel)
    large = max_exact + (np.log(np.maximum(n, 1) / max_exact) / np.log(MAX_DISTANCE / max_exact)
                         * (nb - max_exact)).astype(np.int32)
    large = np.minimum(large, nb - 1)
    return (ret + np.where(n < max_exact, n, large)).astype(np.int32)


def t5_bias(table_cols, blk, d):
    rel = (np.arange(3 * blk)[None, :] - blk - np.arange(blk)[:, None]) * d
    return table_cols[t5_bucket(rel)].transpose(2, 0, 1).astype(jnp.float32)


def banded_attention(q, k, v, half_w, blk, bias, sink=None):
    n, L, H, dh = q.shape
    G = k.shape[2]
    rep = H // G
    nb = -(-L // blk)
    Lp = nb * blk
    qb = jnp.pad(q, ((0, 0), (0, Lp - L), (0, 0), (0, 0))).reshape(n, nb, blk, G, rep, dh)

    def windows(t):
        tp = jnp.pad(t, ((0, 0), (blk, Lp - L + blk), (0, 0), (0, 0))).reshape(n, nb + 2, blk, G, dh)
        return jnp.concatenate([tp[:, :-2], tp[:, 1:-1], tp[:, 2:]], axis=2)

    kb, vb = windows(k), windows(v)
    qpos = np.arange(Lp).reshape(nb, blk)
    kpos = np.arange(-blk, Lp + blk).reshape(nb + 2, blk)
    kpos = np.concatenate([kpos[:-2], kpos[1:-1], kpos[2:]], axis=1)
    rel = kpos[:, None, :] - qpos[:, :, None]
    mask = (np.abs(rel) <= half_w) & (kpos[:, None, :] >= 0) & (kpos[:, None, :] < L)

    s = jnp.einsum('nbqgrd,nbkgd->nbgrqk', qb, kb, preferred_element_type=jnp.float32) * SCALE
    s = s + bias.reshape(G, rep, blk, 3 * blk)[None, None]
    s = jnp.where(mask[None, :, None, None], s, NEG_INF)
    m = jnp.max(s, axis=-1)
    if sink is not None:
        sk = sink.astype(jnp.float32).reshape(G, rep, 1)
        m = jnp.maximum(m, sk)
    p = jnp.exp(s - m[..., None])
    den = jnp.sum(p, axis=-1)
    if sink is not None:
        den = den + jnp.exp(sk - m)
    o = jnp.einsum('nbgrqk,nbkgd->nbqgrd', p.astype(v.dtype), vb, preferred_element_type=jnp.float32)
    den_t = jnp.moveaxis(den, -1, 2)
    lse = jnp.moveaxis(m, -1, 2) + jnp.log(den_t)
    o = (o / den_t[..., None]).reshape(n, Lp, H, dh)[:, :L]
    lse = lse.reshape(n, Lp, H)[:, :L]
    return o, lse


def dilated_attention(q, k, v, d, half, bias):
    Bn, T, H, dh = q.shape

    def split(t):
        return t.reshape(Bn, T // d, d, H, dh).transpose(0, 2, 1, 3, 4).reshape(Bn * d, T // d, H, dh)

    o, lse = banded_attention(split(q), split(k), split(v), half, half, bias)
    o = o.reshape(Bn, d, T // d, H, dh).transpose(0, 2, 1, 3, 4).reshape(Bn, T, H, dh)
    lse = lse.reshape(Bn, d, T // d, H).transpose(0, 2, 1, 3).reshape(Bn, T, H)
    return o, lse


def mixer_ab(h, w_in, w_out, sink, t5_table):
    Bn, T, _ = h.shape
    proj = h @ w_in
    a = proj[..., :A_IN].reshape(Bn, T, len(DILATIONS), 3, A_HEADS_PER_GROUP, HEAD_DIM)
    b = proj[..., A_IN:]
    nq = B_Q_HEADS * HEAD_DIM
    nkv = B_KV_HEADS * HEAD_DIM
    bq = b[..., :nq].reshape(Bn, T, B_Q_HEADS, HEAD_DIM)
    bk = b[..., nq:nq + nkv].reshape(Bn, T, B_KV_HEADS, HEAD_DIM)
    bv = b[..., nq + nkv:].reshape(Bn, T, B_KV_HEADS, HEAD_DIM)
    outs, lses = [], []
    for g, (w, d) in enumerate(DILATIONS):
        half = w // (2 * d)
        cols = t5_table[:, g * A_HEADS_PER_GROUP:(g + 1) * A_HEADS_PER_GROUP]
        o, l = dilated_attention(a[:, :, g, 0], a[:, :, g, 1], a[:, :, g, 2], d, half, t5_bias(cols, half, d))
        outs.append(o)
        lses.append(l)
    wts = jax.nn.softmax(jnp.stack(lses), axis=0)
    o_a = jnp.sum(wts[..., None] * jnp.stack(outs), axis=0)
    o_b, _ = banded_attention(bq, bk, bv, B_HALF_WINDOW, B_BLOCK,
                              t5_bias(t5_table[:, A_HEADS:], B_BLOCK, 1), sink)
    mixed = jnp.concatenate([o_a.reshape(Bn, T, -1), o_b.reshape(Bn, T, -1)], axis=-1).astype(h.dtype)
    return mixed @ w_out


def neighbourhood_attention(q, k, v, rpb):
    Bn, T, H, dh = q.shape
    rows = T // GRID_W
    kh = min(NA_ROWS, rows)
    r = np.arange(rows)
    rs = np.clip(r - kh // 2, 0, rows - kh)
    key_rows = rs[:, None] + np.arange(kh)[None, :]
    c = np.arange(GRID_W)
    cs = np.clip(c - NA_COLS // 2, 0, GRID_W - NA_COLS)
    col_mask = (c[None, :] >= cs[:, None]) & (c[None, :] < cs[:, None] + NA_COLS)
    dr = key_rows - r[:, None] + NA_ROWS - 1
    dc = np.clip(c[None, :] - c[:, None] + NA_COLS - 1, 0, 2 * NA_COLS - 2)
    bias = rpb[:, dr[:, None, :, None], dc[None, :, None, :]].astype(jnp.float32)
    bias = bias.transpose(1, 0, 2, 3, 4)
    qg = q.reshape(Bn, rows, GRID_W, H, dh)
    kg = k.reshape(Bn, rows, GRID_W, H, dh)[:, key_rows]
    vg = v.reshape(Bn, rows, GRID_W, H, dh)[:, key_rows]
    s = jnp.einsum('brqhd,brikhd->brhqik', qg, kg, preferred_element_type=jnp.float32) * SCALE + bias[None]
    s = jnp.where(col_mask[:, None, :], s, NEG_INF)
    p = jax.nn.softmax(s.reshape(Bn, rows, H, GRID_W, kh * GRID_W), axis=-1).reshape(s.shape)
    o = jnp.einsum('brhqik,brikhd->brqhd', p.astype(v.dtype), vg, preferred_element_type=jnp.float32)
    return o.reshape(Bn, T, H, dh)


def mixer_c(h, w_in, w_out, rpb):
    Bn, T, _ = h.shape
    qkv = (h @ w_in).reshape(Bn, T, 3, C_HEADS, HEAD_DIM)
    o = neighbourhood_attention(qkv[:, :, 0], qkv[:, :, 1], qkv[:, :, 2], rpb)
    return o.reshape(Bn, T, C_OUT).astype(h.dtype) @ w_out


def swiglu(h, w_gate, w_up, w_down):
    return (jax.nn.silu(h @ w_gate) * (h @ w_up)) @ w_down


def trunk(x, w_in_ab, w_out_ab, sink_b, w_in_c, w_out_c, rpb_c, t5_table,
          norm_mix, norm_ffn, w_gate, w_up, w_down, norm_final):
    for layer in range(DEPTH):
        j = layer // 2
        h = rms_norm(x, norm_mix[layer])
        if layer % 2 == 0:
            x = x + mixer_ab(h, w_in_ab[j], w_out_ab[j], sink_b[j], t5_table)
        else:
            x = x + mixer_c(h, w_in_c[j], w_out_c[j], rpb_c[j])
        x = x + swiglu(rms_norm(x, norm_ffn[layer]), w_gate[layer], w_up[layer], w_down[layer])
    return rms_norm(x, norm_final)


def setup_inputs(seed: int = 0) -> dict:
    key = jax.random.key(seed)
    ks = jax.random.split(key, 17)
    n_even = (DEPTH + 1) // 2
    n_odd = DEPTH // 2
    nrm = jax.random.normal
    f32 = jnp.float32
    return {
        'x_prompt': nrm(ks[0], (BATCH, SEQ, D_MODEL), f32),
        'x_sample': nrm(ks[1], (DEC_BATCH, DEC_SEQ, D_MODEL), f32),
        'w_in_ab': nrm(ks[2], (n_even, D_MODEL, AB_IN), f32) * D_MODEL ** -0.5,
        'w_out_ab': nrm(ks[3], (n_even, AB_OUT, D_MODEL), f32) * AB_OUT ** -0.5,
        'sink_b': 0.5 * nrm(ks[4], (n_even, B_Q_HEADS), f32),
        'w_in_c': nrm(ks[5], (n_odd, D_MODEL, C_IN), f32) * D_MODEL ** -0.5,
        'w_out_c': nrm(ks[6], (n_odd, C_OUT, D_MODEL), f32) * C_OUT ** -0.5,
        'rpb_c': 0.2 * nrm(ks[7], (n_odd, C_HEADS, 2 * NA_ROWS - 1, 2 * NA_COLS - 1), f32),
        't5_table': 0.2 * nrm(ks[8], (NUM_BUCKETS, A_HEADS + B_Q_HEADS), f32),
        'norm_mix': 1.0 + 0.05 * nrm(ks[9], (DEPTH, D_MODEL), f32),
        'norm_ffn': 1.0 + 0.05 * nrm(ks[10], (DEPTH, D_MODEL), f32),
        'w_gate': nrm(ks[11], (DEPTH, D_MODEL, D_FF), f32) * D_MODEL ** -0.5,
        'w_up': nrm(ks[12], (DEPTH, D_MODEL, D_FF), f32) * D_MODEL ** -0.5,
        'w_down': nrm(ks[13], (DEPTH, D_FF, D_MODEL), f32) * D_FF ** -0.5,
        'norm_final': 1.0 + 0.05 * nrm(ks[14], (D_MODEL,), f32),
    }


def reference(x_prompt, x_sample, w_in_ab, w_out_ab, sink_b, w_in_c, w_out_c, rpb_c, t5_table,
              norm_mix, norm_ffn, w_gate, w_up, w_down, norm_final):
    y_prompt = trunk(x_prompt, w_in_ab, w_out_ab, sink_b, w_in_c, w_out_c, rpb_c, t5_table,
                     norm_mix, norm_ffn, w_gate, w_up, w_down, norm_final)
    y_sample = trunk(x_sample, w_in_ab, w_out_ab, sink_b, w_in_c, w_out_c, rpb_c, t5_table,
                     norm_mix, norm_ffn, w_gate, w_up, w_down, norm_final)
    return (y_prompt, y_sample)
```

```cpp
#include <hip/hip_runtime.h>
#include <cstdio>
#include <cstdint>
namespace pg8 {
#define PG8_LAS __attribute__((address_space(3)))
typedef unsigned short bf16_t;
typedef short bf16x8 __attribute__((ext_vector_type(8)));
typedef float f32x4 __attribute__((ext_vector_type(4)));
typedef unsigned u32x4 __attribute__((ext_vector_type(4)));
constexpr int BM = 256, BK = 64, HALF = 128, HTB = HALF * BK * 2  , STAGE_BYTES = 8 * HTB, NXCD = 8, WGM = 8;

__host__ __device__ __forceinline__ int lds_byte(int r, int c) { const int st = (r >> 4) * 2 + (c >> 5), rr = r & 15, cc = c & 31, ob = rr * 64 + cc * 2; return st * 1024 + (ob ^ (((ob >> 9) & 1) << 5)); }
__host__ __device__ __forceinline__ void stage_rc(int b, int& R, int& C) { const int st = b / 1024, sb = b % 1024, swz = sb ^ (((sb >> 9) & 1) << 5); R = (st >> 1) * 16 + swz / 64; C = (st & 1) * 32 + (swz % 64) / 2; }
__host__ __device__ __forceinline__ int perm32(int rho) { const int n = rho >> 4, i = rho & 15; return 8 * (i >> 2) + 4 * n + (i & 3); }

struct Unit { int pm, pn; };
struct Gemm { const bf16_t* A; const bf16_t* Bt; int M, N, K; };

struct StaticOrder {
    int nM, nN, nwg, G, c;
    __host__ __device__ void init(int M, int N, int G_, int c_) { nM = M / BM; nN = N / BM; nwg = nM * nN; G = G_; c = c_; }
    __host__ __device__ bool next(int i, Unit& u) const {
        const long L = (long)i * G + c; if (L >= nwg) return false;
        int wgid = (int)L; { const int q = nwg / NXCD, r = nwg % NXCD, xcd = wgid % NXCD, off = wgid / NXCD; wgid = (xcd < r ? xcd * (q + 1) : r * (q + 1) + (xcd - r) * q) + off; }
        const int nig = WGM * nN, gid = wgid / nig, fm = gid * WGM, gsz = (nM - fm) < WGM ? (nM - fm) : WGM;
        u.pm = fm + ((wgid % nig) % gsz); u.pn = (wgid % nig) / gsz; return true;
    }
    __device__ __forceinline__ void a_ready(const Unit&) const {}
    __device__ __forceinline__ void done(const Unit&) const {}
};

__device__ __forceinline__ unsigned cvt_pk_bf16(float lo, float hi) { unsigned r; asm volatile("v_cvt_pk_bf16_f32 %0, %1, %2" : "=v"(r) : "v"(lo), "v"(hi)); return r; }
typedef unsigned long long u64;
constexpr float RMS_EPS_F = 1e-6f, SSQ_FIX = 1048576.0f;
__device__ __forceinline__ float rstd_of(const u64* ssq, int row) { const u64 v = __hip_atomic_load(ssq + row, __ATOMIC_RELAXED, __HIP_MEMORY_SCOPE_AGENT); return 1.0f / sqrtf((float)v * (1.0f / (2048.0f * SSQ_FIX)) + RMS_EPS_F); }

struct EpiProj {
    static constexpr bool PERM = true, AFTER_DRAIN = false;
    bf16_t* O; int ldc; const u64* ssq;
    __device__ __forceinline__ void operator()(const f32x4 (&acc)[2][2][4][2], const Unit& u, int wr, int wc, int fr, int fq) const {
        const int row0 = u.pm * BM + wr * 64 + fr, col0 = u.pn * BM + wc * 32 + 8 * fq;
#pragma unroll
        for (int ai = 0; ai < 2; ++ai)
#pragma unroll
            for (int m = 0; m < 4; ++m) { const int row = row0 + ai * HALF + m * 16; const float rs = rstd_of(ssq, row); bf16_t* rowp = O + (size_t)row * ldc + col0;
#pragma unroll
                for (int bj = 0; bj < 2; ++bj) { const f32x4 v0 = acc[ai][bj][m][0] * rs, v1 = acc[ai][bj][m][1] * rs;
                    u32x4 w; w.x = cvt_pk_bf16(v0[0], v0[1]); w.y = cvt_pk_bf16(v0[2], v0[3]); w.z = cvt_pk_bf16(v1[0], v1[1]); w.w = cvt_pk_bf16(v1[2], v1[3]);
                    *(u32x4*)(rowp + bj * HALF) = w; } }
    }
};
struct EpiResid {
    static constexpr bool PERM = true, AFTER_DRAIN = false;
    float* X; bf16_t* XB; u64* ssq_out; int ldc;
    __device__ __forceinline__ void operator()(const f32x4 (&acc)[2][2][4][2], const Unit& u, int wr, int wc, int fr, int fq) const {
        const int row0 = u.pm * BM + wr * 64 + fr, col0 = u.pn * BM + wc * 32 + 8 * fq;
#pragma unroll
        for (int ai = 0; ai < 2; ++ai)
#pragma unroll
            for (int m = 0; m < 4; ++m) { const int row = row0 + ai * HALF + m * 16; float* xp = X + (size_t)row * ldc + col0; bf16_t* bp = XB + (size_t)row * ldc + col0; float part = 0.f;
#pragma unroll
                for (int bj = 0; bj < 2; ++bj) { f32x4 v0 = *(const f32x4*)(xp + bj * HALF), v1 = *(const f32x4*)(xp + bj * HALF + 4);
                    v0 = v0 + acc[ai][bj][m][0]; v1 = v1 + acc[ai][bj][m][1];
                    *(f32x4*)(xp + bj * HALF) = v0; *(f32x4*)(xp + bj * HALF + 4) = v1;
                    part += (v0[0] * v0[0] + v0[1] * v0[1]) + (v0[2] * v0[2] + v0[3] * v0[3]) + (v1[0] * v1[0] + v1[1] * v1[1]) + (v1[2] * v1[2] + v1[3] * v1[3]);
                    u32x4 w; w.x = cvt_pk_bf16(v0[0], v0[1]); w.y = cvt_pk_bf16(v0[2], v0[3]); w.z = cvt_pk_bf16(v1[0], v1[1]); w.w = cvt_pk_bf16(v1[2], v1[3]);
                    *(u32x4*)(bp + bj * HALF) = w; }
                part += __shfl_xor(part, 16); part += __shfl_xor(part, 32);
                if (fq == 0) atomicAdd(ssq_out + row, (u64)(part * SSQ_FIX));
                asm volatile("" ::: "memory"); }
    }
};
struct EpiGateUp {
    static constexpr bool PERM = true, AFTER_DRAIN = false;
    bf16_t* O; int ldc; const u64* ssq;
    __device__ __forceinline__ static float silu_mul(float g, float uu) { const float e = __builtin_amdgcn_exp2f(g * -1.4426950408889634f); return g * __builtin_amdgcn_rcpf(1.0f + e) * uu; }
    __device__ __forceinline__ void operator()(const f32x4 (&acc)[2][2][4][2], const Unit& u, int wr, int wc, int fr, int fq) const {
        const int row0 = u.pm * BM + wr * 64 + fr, col0 = u.pn * HALF + wc * 32 + 8 * fq;
#pragma unroll
        for (int ai = 0; ai < 2; ++ai)
#pragma unroll
            for (int m = 0; m < 4; ++m) { const int row = row0 + ai * HALF + m * 16; const float rs = rstd_of(ssq, row);
                const f32x4 g0 = acc[ai][0][m][0] * rs, g1 = acc[ai][0][m][1] * rs, u0 = acc[ai][1][m][0] * rs, u1 = acc[ai][1][m][1] * rs;
                u32x4 w; w.x = cvt_pk_bf16(silu_mul(g0[0], u0[0]), silu_mul(g0[1], u0[1])); w.y = cvt_pk_bf16(silu_mul(g0[2], u0[2]), silu_mul(g0[3], u0[3]));
                w.z = cvt_pk_bf16(silu_mul(g1[0], u1[0]), silu_mul(g1[1], u1[1])); w.w = cvt_pk_bf16(silu_mul(g1[2], u1[2]), silu_mul(g1[3], u1[3]));
                *(u32x4*)(O + (size_t)row * ldc + col0) = w; }
    }
};

template <class Epi, class Sched, bool ALIGN_EPI = false, bool SP2 = false>
__device__ __forceinline__ void gemm_phase(PG8_LAS unsigned char* lds, const Gemm g, const Sched& S, const Epi& E) {
    const int tid = threadIdx.x, wid = __builtin_amdgcn_readfirstlane(tid >> 6), lane = tid & 63, wr = wid >> 2, wc = wid & 3, fr = lane & 15, fq = lane >> 4;
    const int K = g.K, nt = K / BK;
    unsigned voffA[2], voffB[2];
#pragma unroll
    for (int i = 0; i < 2; ++i) { int R, C; stage_rc(tid * 16 + i * 8192, R, C); const int Rb = Epi::PERM ? ((R & ~31) + perm32(R & 31)) : R;
        voffA[i] = (unsigned)(R * K + C) * 2u; voffB[i] = (unsigned)(Rb * K + C) * 2u; }
    const size_t kstep = (size_t)(BK * 2);
    const size_t hstep = (size_t)HALF * K * 2;
    const size_t tstep = 2 * hstep;
    const unsigned ldsw = (unsigned)wid * 1024u;
    const int aoff = lds_byte(wr * 64 + fr, fq * 8), boff = lds_byte(wc * 32 + fr, fq * 8);
#define PG8_SA(b, h) (((b) * 2 + (h)) * HTB)
#define PG8_SB(b, h) ((4 + (b) * 2 + (h)) * HTB)
#define PG8_STAGE(bufoff, gbase, voff) do { _Pragma("unroll") for (int _i = 0; _i < 2; ++_i) \
        __builtin_amdgcn_global_load_lds((const unsigned*)((const char*)(gbase) + (voff)[_i]), (PG8_LAS unsigned*)(lds + (bufoff) + ldsw + _i * 8192), 16, 0, 0); } while (0)
#define PG8_LDA(dst, b, h) do { _Pragma("unroll") for (int m = 0; m < 4; ++m) _Pragma("unroll") for (int k = 0; k < 2; ++k) dst[m][k] = *(const PG8_LAS bf16x8*)(lds + PG8_SA(b, h) + aoff + m * 2048 + k * 1024); } while (0)
#define PG8_LDB(dst, b, h) do { _Pragma("unroll") for (int n = 0; n < 2; ++n) _Pragma("unroll") for (int k = 0; k < 2; ++k) dst[n][k] = *(const PG8_LAS bf16x8*)(lds + PG8_SB(b, h) + boff + n * 2048 + k * 1024); } while (0)
#define PG8_MMA(ai, bj, At, Bt) do { __builtin_amdgcn_s_setprio(1); _Pragma("unroll") for (int m = 0; m < 4; ++m) _Pragma("unroll") for (int n = 0; n < 2; ++n) _Pragma("unroll") for (int k = 0; k < 2; ++k) \
        acc[ai][bj][m][n] = __builtin_amdgcn_mfma_f32_16x16x32_bf16(Bt[n][k], At[m][k], acc[ai][bj][m][n], 0, 0, 0); __builtin_amdgcn_s_setprio(0); } while (0)
#define PG8_WAIT_V(n) asm volatile("s_waitcnt vmcnt(" #n ")" ::: "memory")
#define PG8_WAIT_L(n) asm volatile("s_waitcnt lgkmcnt(" #n ")" ::: "memory")
#define PG8_BAR __builtin_amdgcn_s_barrier()
#define PG8_SCHED __builtin_amdgcn_sched_barrier(0)
    Unit cur, nxt; int ui = 0;
    if (!S.next(0, cur)) return;
    f32x4 acc[2][2][4][2];
#pragma unroll
    for (int a = 0; a < 2; ++a)
#pragma unroll
        for (int b = 0; b < 2; ++b)
#pragma unroll
            for (int m = 0; m < 4; ++m)
#pragma unroll
                for (int n = 0; n < 2; ++n) acc[a][b][m][n] = (f32x4){0.f, 0.f, 0.f, 0.f};
    bf16x8 At[4][2], B0[2][2], B1[2][2];
    const char* cA = (const char*)g.A + (size_t)cur.pm * tstep; const char* cB = (const char*)g.Bt + (size_t)cur.pn * tstep;
    S.a_ready(cur);
    if constexpr (SP2) {
        PG8_STAGE(PG8_SB(0, 0), cB, voffB); PG8_STAGE(PG8_SB(0, 1), cB + hstep, voffB); PG8_STAGE(PG8_SA(0, 0), cA, voffA); PG8_STAGE(PG8_SA(0, 1), cA + hstep, voffA);
        if (wr == 1) PG8_BAR;
        PG8_WAIT_V(2); PG8_BAR;
        PG8_STAGE(PG8_SB(1, 0), cB + kstep, voffB); PG8_STAGE(PG8_SA(1, 0), cA + kstep, voffA); PG8_STAGE(PG8_SB(1, 1), cB + hstep + kstep, voffB);
        PG8_WAIT_V(6); PG8_BAR;
    } else {
        PG8_STAGE(PG8_SB(0, 0), cB, voffB); PG8_STAGE(PG8_SA(0, 0), cA, voffA); PG8_STAGE(PG8_SB(0, 1), cB + hstep, voffB); PG8_STAGE(PG8_SA(0, 1), cA + hstep, voffA);
        if (wr == 1) PG8_BAR;
        PG8_WAIT_V(4); PG8_BAR;
        PG8_STAGE(PG8_SB(1, 0), cB + kstep, voffB); PG8_STAGE(PG8_SA(1, 0), cA + kstep, voffA); PG8_STAGE(PG8_SB(1, 1), cB + hstep + kstep, voffB);
        PG8_WAIT_V(6); PG8_BAR;
    }
    for (;;) {
        const bool has_next = S.next(ui + 1, nxt);
        const char* nA = has_next ? (const char*)g.A + (size_t)nxt.pm * tstep : cA; const char* nB = has_next ? (const char*)g.Bt + (size_t)nxt.pn * tstep : cB;
        for (int t = 0; t < nt; t += 2) {
            const bool last = (t == nt - 2);
            const char* a1 = cA + (size_t)(t + 1) * kstep;
            const char* a2 = last ? nA : cA + (size_t)(t + 2) * kstep; const char* b2 = last ? nB : cB + (size_t)(t + 2) * kstep;
            const char* a3 = a2 + kstep; const char* b3 = b2 + kstep;
            if (last && has_next) S.a_ready(nxt);
            if constexpr (SP2) {
            PG8_LDB(B0, 0, 0); PG8_LDB(B1, 0, 1); PG8_SCHED; PG8_LDA(At, 0, 0); PG8_STAGE(PG8_SA(1, 1), a1 + hstep, voffA);
            PG8_WAIT_V(8); PG8_WAIT_L(0); PG8_BAR; PG8_MMA(0, 0, At, B0); PG8_MMA(0, 1, At, B1); PG8_BAR; PG8_SCHED;
            PG8_LDA(At, 0, 1); PG8_STAGE(PG8_SB(0, 0), b2, voffB); PG8_STAGE(PG8_SB(0, 1), b2 + hstep, voffB); PG8_STAGE(PG8_SA(0, 0), a2, voffA);
            PG8_WAIT_V(8); PG8_WAIT_L(0); PG8_BAR; PG8_MMA(1, 0, At, B0); PG8_MMA(1, 1, At, B1); PG8_BAR; PG8_SCHED;
            PG8_LDB(B0, 1, 0); PG8_LDB(B1, 1, 1); PG8_SCHED; PG8_LDA(At, 1, 0); PG8_STAGE(PG8_SA(0, 1), a2 + hstep, voffA);
            PG8_WAIT_V(8); PG8_WAIT_L(0); PG8_BAR; PG8_MMA(0, 0, At, B0); PG8_MMA(0, 1, At, B1); PG8_BAR; PG8_SCHED;
            PG8_LDA(At, 1, 1); PG8_STAGE(PG8_SB(1, 0), b3, voffB); PG8_STAGE(PG8_SB(1, 1), b3 + hstep, voffB); PG8_STAGE(PG8_SA(1, 0), a3, voffA);
            PG8_WAIT_V(8); PG8_WAIT_L(0); PG8_BAR; PG8_MMA(1, 0, At, B0); PG8_MMA(1, 1, At, B1); PG8_BAR; PG8_SCHED;
            } else {
            PG8_LDB(B0, 0, 0); PG8_SCHED; PG8_LDA(At, 0, 0); PG8_STAGE(PG8_SA(1, 1), a1 + hstep, voffA);
            PG8_WAIT_L(8); PG8_BAR; PG8_WAIT_L(0); PG8_MMA(0, 0, At, B0); PG8_BAR; PG8_SCHED;
            PG8_LDB(B1, 0, 1); PG8_STAGE(PG8_SB(0, 0), b2, voffB);
            PG8_BAR; PG8_WAIT_L(0); PG8_MMA(0, 1, At, B1); PG8_BAR;
            PG8_LDA(At, 0, 1); PG8_STAGE(PG8_SA(0, 0), a2, voffA);
            PG8_BAR; PG8_WAIT_L(0); PG8_MMA(1, 0, At, B0); PG8_BAR; PG8_SCHED;
            PG8_STAGE(PG8_SB(0, 1), b2 + hstep, voffB);
            PG8_WAIT_V(6); PG8_BAR; PG8_MMA(1, 1, At, B1); PG8_BAR;
            PG8_LDB(B0, 1, 0); PG8_SCHED; PG8_LDA(At, 1, 0); PG8_STAGE(PG8_SA(0, 1), a2 + hstep, voffA);
            PG8_WAIT_L(8); PG8_BAR; PG8_WAIT_L(0); PG8_MMA(0, 0, At, B0); PG8_BAR; PG8_SCHED;
            PG8_LDB(B1, 1, 1); PG8_STAGE(PG8_SB(1, 0), b3, voffB);
            PG8_BAR; PG8_WAIT_L(0); PG8_MMA(0, 1, At, B1); PG8_BAR;
            PG8_LDA(At, 1, 1); PG8_STAGE(PG8_SA(1, 0), a3, voffA);
            PG8_BAR; PG8_WAIT_L(0); PG8_MMA(1, 0, At, B0); PG8_BAR; PG8_SCHED;
            PG8_STAGE(PG8_SB(1, 1), b3 + hstep, voffB);
            PG8_WAIT_V(6); PG8_BAR; PG8_MMA(1, 1, At, B1); PG8_BAR;
            }
        }
        if constexpr (ALIGN_EPI) { if (wr == 0) PG8_BAR; }
        if constexpr (!Epi::AFTER_DRAIN) { E(acc, cur, wr, wc, fr, fq); S.done(cur); }
        if (!has_next) break;
#pragma unroll
        for (int a = 0; a < 2; ++a)
#pragma unroll
            for (int b = 0; b < 2; ++b)
#pragma unroll
                for (int m = 0; m < 4; ++m)
#pragma unroll
                    for (int n = 0; n < 2; ++n) acc[a][b][m][n] = (f32x4){0.f, 0.f, 0.f, 0.f};
        cur = nxt; cA = nA; cB = nB; ++ui;
        if constexpr (ALIGN_EPI) { if (wr == 1) PG8_BAR; }
    }
    PG8_WAIT_V(0);
    if constexpr (!ALIGN_EPI) { if (wr == 0) PG8_BAR; }
    PG8_BAR;
    if constexpr (Epi::AFTER_DRAIN) { E.fused(acc, cur, wr, wc, fr, fq, lds, wid, lane); S.done(cur); }
#undef PG8_SA
#undef PG8_SB
#undef PG8_STAGE
#undef PG8_LDA
#undef PG8_LDB
#undef PG8_MMA
#undef PG8_WAIT_V
#undef PG8_WAIT_L
#undef PG8_BAR
#undef PG8_SCHED
}
}

constexpr int NWAVES = 8;
#ifndef MK_PER_PHASE
#define MK_PER_PHASE 1
#endif
constexpr bool PER_PHASE_LAUNCH = MK_PER_PHASE != 0;

constexpr int D = 2048, FF = 5632, NGU = 2 * FF, NPROJ = 6144, DEPTH = 4;
constexpr int M_PROMPT = 4 * 4096, M_SAMPLE = 4 * 8192, M = M_PROMPT + M_SAMPLE;
constexpr int N_PHASES = 2 + 5 * DEPTH;
constexpr float SM_SCALE = 0.08838834764831845f, LOG2E = 1.4426950408889634f;

constexpr size_t MiB = 1u << 20;
constexpr size_t WS_CTL = 0, CTL_ZERO_BYTES = 8 * MiB;
constexpr size_t WS_SSQ = 1 * MiB;
constexpr size_t WS_WIN = 8 * MiB, WS_WOUT = 32 * MiB, WS_WGU = 40 * MiB, WS_WDN = 84 * MiB;
constexpr size_t WS_XB = 108 * MiB;
constexpr size_t WS_MIX = 300 * MiB;
constexpr size_t WS_PROJ = 492 * MiB;
constexpr size_t WS_END = 1068 * MiB;
static_assert(WS_SSQ + 9ull * M * 8 <= CTL_ZERO_BYTES && WS_WIN + (size_t)NPROJ * D * 2 <= WS_WOUT && WS_WOUT + (size_t)D * D * 2 <= WS_WGU && WS_WGU + (size_t)NGU * D * 2 <= WS_WDN &&
              WS_WDN + (size_t)D * FF * 2 <= WS_XB && WS_XB + (size_t)M * D * 2 <= WS_MIX && WS_MIX + (size_t)M * D * 2 <= WS_PROJ && WS_PROJ + (size_t)M * NPROJ * 2 <= WS_END, "d_ws map");
constexpr int CW_BAR = 4096;

constexpr int RING_OFF = 0, RING_BYTES = 131072;
constexpr int LDSCTL_OFF = RING_BYTES, MISC_OFF = LDSCTL_OFF + 320;
constexpr int LDS_BYTES = 147456;
static_assert(MISC_OFF + 128 <= LDS_BYTES, "LDS map");

#define GAS __attribute__((address_space(1)))
#define LAS __attribute__((address_space(3)))
typedef unsigned short bf16;
typedef unsigned v4u __attribute__((ext_vector_type(4)));
typedef unsigned v2u __attribute__((ext_vector_type(2)));
typedef float f32x4 __attribute__((ext_vector_type(4)));
typedef GAS unsigned gu32;
#define RLX_AGENT __ATOMIC_RELAXED, __HIP_MEMORY_SCOPE_AGENT
#define LDS_WAIT() asm volatile("s_waitcnt lgkmcnt(0)" ::: "memory")
#define VM_WAIT() asm volatile("s_waitcnt vmcnt(0)" ::: "memory")
__device__ __forceinline__ unsigned f2bf(float f) { unsigned u = __builtin_bit_cast(unsigned, f); return (u + 0x7fffu + ((u >> 16) & 1u)) >> 16; }
__device__ __forceinline__ unsigned pk2(float lo, float hi) { return f2bf(lo) | (f2bf(hi) << 16); }
__device__ __forceinline__ float bf_lo(unsigned w) { return __builtin_bit_cast(float, w << 16); }
__device__ __forceinline__ float bf_hi(unsigned w) { return __builtin_bit_cast(float, w & 0xffff0000u); }

#define XB_TMO      128
#define XB_XCNT(j)  (256  + 64 * (j))
#define XB_XSUB(j)  (1280 + 64 * (j))
#define XB_XGEN(j)  (2304 + 64 * (j))
#define XB_TOP      3328
#define XB_TOPGEN   3392
#define XCD_BAR_WORDS 3456
#define XB_SPIN_CAP (1u << 18)

__device__ __forceinline__ unsigned xb_ld(unsigned* p)              { return __hip_atomic_load(p, __ATOMIC_RELAXED, __HIP_MEMORY_SCOPE_AGENT); }
__device__ __forceinline__ unsigned xb_add(unsigned* p, unsigned v) { return __hip_atomic_fetch_add(p, v, __ATOMIC_RELAXED, __HIP_MEMORY_SCOPE_AGENT); }
__device__ __forceinline__ unsigned xb_xcc_id() { return (unsigned)__builtin_amdgcn_s_getreg((3 << 11) | 20) & 0xFu; }
#define XB_SPIN(cond, bar) do { unsigned _sp = 0; while (cond) { __builtin_amdgcn_s_sleep(1); \
    if ((++_sp & 255u) == 0u) { if (xb_ld(&(bar)[XB_TMO])) break; if (_sp > XB_SPIN_CAP) { atomicAdd(&(bar)[XB_TMO], 1u); break; } } } } while (0)

struct XcdBarrier {
    unsigned* bar; unsigned x;
    volatile LAS unsigned* st;
};

__device__ __forceinline__ XcdBarrier xcd_barrier_post(unsigned* bar, volatile LAS unsigned* st) {
    XcdBarrier b; b.bar = bar; b.x = xb_xcc_id(); b.st = st;
    if (threadIdx.x == 0) (void)xb_add(&bar[XB_XCNT(b.x)], 1u);
    return b;
}
__device__ __forceinline__ void xcd_barrier_complete(unsigned* bar, unsigned x, unsigned& nloc, unsigned& nx) {
    const unsigned G = gridDim.x * gridDim.y * gridDim.z;
    unsigned sum, cnt, mine, sp = 0u;
    for (;;) {
        sum = 0u; cnt = 0u; mine = 0u;
#pragma unroll
        for (unsigned j = 0; j < 16; ++j) { const unsigned c = xb_ld(&bar[XB_XCNT(j)]); sum += c; cnt += (c > 0u) ? 1u : 0u; mine = (j == x) ? c : mine; }
        if (sum == G) break;
        __builtin_amdgcn_s_sleep(1);
        if ((++sp & 255u) == 0u) { if (xb_ld(&bar[XB_TMO])) break; if (sp > XB_SPIN_CAP) { atomicAdd(&bar[XB_TMO], 1u); break; } }
    }
    nloc = mine > 0u ? mine : 1u; nx = cnt > 0u ? cnt : 1u;
}

__device__ __forceinline__ void xcd_barrier(const XcdBarrier& b) {
    asm volatile("s_waitcnt vmcnt(0)" ::: "memory");
    __syncthreads();
    if (threadIdx.x == 0) {
        unsigned* bar = b.bar;
        __builtin_amdgcn_s_waitcnt(0);
        unsigned nloc = b.st[0], nx = b.st[1];
        if (nloc == 0u) { xcd_barrier_complete(bar, b.x, nloc, nx); b.st[0] = nloc; b.st[1] = nx; }
        const unsigned old = xb_add(&bar[XB_XSUB(b.x)], 1u);
        const unsigned gen = old / nloc;
        if (old + 1u == (gen + 1u) * nloc) {
            __builtin_amdgcn_fence(__ATOMIC_RELEASE, "agent");
            asm volatile("s_waitcnt vmcnt(0)" ::: "memory");
            const unsigned og = xb_add(&bar[XB_TOP], 1u);
            const unsigned tg = og / nx;
            if (og + 1u == (tg + 1u) * nx) xb_add(&bar[XB_TOPGEN], 1u);
            else XB_SPIN(xb_ld(&bar[XB_TOPGEN]) == tg, bar);
            __builtin_amdgcn_fence(__ATOMIC_ACQUIRE, "agent");
            xb_add(&bar[XB_XGEN(b.x)], 1u);
            asm volatile("s_waitcnt vmcnt(0)" ::: "memory");
        } else {
            XB_SPIN(xb_ld(&bar[XB_XGEN(b.x)]) == gen, bar);
            __builtin_amdgcn_fence(__ATOMIC_ACQUIRE, "agent");
            asm volatile("s_waitcnt vmcnt(0)" ::: "memory");
        }
    }
    __syncthreads();
}

__device__ __forceinline__ float wave_sum(float v) {
#pragma unroll
    for (int o = 1; o < 64; o <<= 1) v += __shfl_xor(v, o);
    return v;
}
__device__ __forceinline__ void seq_of(int t, int& T, int& sbase) {
    if (t < M_PROMPT) { T = 4096; sbase = t & ~4095; } else { T = 8192; sbase = M_PROMPT + ((t - M_PROMPT) & ~8191); }
}
__device__ __forceinline__ int t5b(int rel) {
    const int n = rel < 0 ? -rel : rel;
    int b = n;
    if (n >= 8) b = 8 + (n >= 15) + (n >= 27) + (n >= 50) + (n >= 91) + (n >= 166) + (n >= 305) + (n >= 559);
    return b + (rel > 0 ? 16 : 0);
}
__device__ __forceinline__ void cvt_item(const float* W, int K, int N, const float* gain, bf16* WT, int mode, LAS float* scr, int item, int lane) {
    const int nblk = N / 32, kb = item / nblk, nb = item % nblk, k0 = 64 * kb, n0 = 32 * nb;
#pragma unroll 8
    for (int i = 0; i < 32; ++i) { const int kk = 2 * i + (lane >> 5); const float g = gain ? gain[k0 + kk] : 1.0f; scr[kk * 33 + (lane & 31)] = W[(size_t)(k0 + kk) * N + n0 + (lane & 31)] * g; }
    LDS_WAIT(); asm volatile("" ::: "memory");
    const int d0 = mode == 0 ? n0 : ((n0 >> 7) * 256 + (n0 & 127) + (mode == 2 ? 128 : 0));
    const int c = lane & 7;
#pragma unroll
    for (int j = 0; j < 4; ++j) { const int n = (lane >> 3) + 8 * j; const LAS float* s = scr + (8 * c) * 33 + n;
        v4u o; o.x = pk2(s[0 * 33], s[1 * 33]); o.y = pk2(s[2 * 33], s[3 * 33]); o.z = pk2(s[4 * 33], s[5 * 33]); o.w = pk2(s[6 * 33], s[7 * 33]);
        *(GAS v4u*)(WT + (size_t)(d0 + n) * K + k0 + 8 * c) = o; }
    LDS_WAIT(); asm volatile("" ::: "memory");
}
__device__ __forceinline__ void cvt_matrix(const float* W, int K, int N, const float* gain, bf16* WT, int mode, LAS float* scr, int gw, int NGW, int lane) {
    const int nitems = (K / 64) * (N / 32);
    for (int it = gw; it < nitems; it += NGW) cvt_item(W, K, N, gain, WT, mode, scr, it, lane);
}
struct LayerW { const float* win; const float* wout; int ko; };
__device__ __forceinline__ LayerW layer_w(const float* const* in, int L) {
    LayerW w; const int j = L >> 1;
    if (L & 1) { w.win = in[5] + (size_t)j * D * NPROJ; w.wout = in[6] + (size_t)j * D * D; w.ko = 2048; }
    else { w.win = in[2] + (size_t)j * D * NPROJ; w.wout = in[3] + (size_t)j * 1536 * D; w.ko = 1536; }
    return w;
}
__device__ __forceinline__ void cvt_win(const float* const* in, unsigned char* ws, int L, LAS float* scr, int gw, int NGW, int lane) {
    const LayerW w = layer_w(in, L);
    cvt_matrix(w.win, D, NPROJ, in[9] + (size_t)L * D, (bf16*)(ws + WS_WIN), 0, scr, gw, NGW, lane);
}
__device__ __forceinline__ void cvt_rest(const float* const* in, unsigned char* ws, int L, LAS float* scr, int gw, int NGW, int lane) {
    const LayerW w = layer_w(in, L);
    cvt_matrix(w.wout, w.ko, D, nullptr, (bf16*)(ws + WS_WOUT), 0, scr, gw, NGW, lane);
    cvt_matrix(in[11] + (size_t)L * D * FF, D, FF, in[10] + (size_t)L * D, (bf16*)(ws + WS_WGU), 1, scr, gw, NGW, lane);
    cvt_matrix(in[12] + (size_t)L * D * FF, D, FF, in[10] + (size_t)L * D, (bf16*)(ws + WS_WGU), 2, scr, gw, NGW, lane);
    cvt_matrix(in[13] + (size_t)L * FF * D, FF, D, nullptr, (bf16*)(ws + WS_WDN), 0, scr, gw, NGW, lane);
}
__device__ __forceinline__ void prologue_rows(const float* xp, const float* xs, float* out, bf16* xb, pg8::u64* ssq0, int gw, int NGW, int lane) {
    for (int row = gw; row < M; row += NGW) {
        const float* src = row < M_PROMPT ? xp + (size_t)row * D : xs + (size_t)(row - M_PROMPT) * D;
        const GAS f32x4* xr = (const GAS f32x4*)src + lane;
        f32x4 v[8]; float s = 0.f;
#pragma unroll
        for (int j = 0; j < 8; ++j) { v[j] = xr[64 * j]; s += (v[j].x * v[j].x + v[j].y * v[j].y) + (v[j].z * v[j].z + v[j].w * v[j].w); }
        s = wave_sum(s);
        GAS f32x4* orow = (GAS f32x4*)(out + (size_t)row * D) + lane;
        GAS v2u* brow = (GAS v2u*)(xb + (size_t)row * D) + lane;
#pragma unroll
        for (int j = 0; j < 8; ++j) { orow[64 * j] = v[j]; v2u w; w.x = pk2(v[j].x, v[j].y); w.y = pk2(v[j].z, v[j].w); brow[64 * j] = w; }
        if (lane == 0) ssq0[row] = (pg8::u64)(s * pg8::SSQ_FIX);
    }
}
__device__ __forceinline__ void final_norm(float* out, const pg8::u64* ssq, const float* gain, int gw, int NGW, int lane) {
    f32x4 g[8];
#pragma unroll
    for (int j = 0; j < 8; ++j) g[j] = ((const GAS f32x4*)gain)[lane + 64 * j];
    for (int row = gw; row < M; row += NGW) {
        const float rs = pg8::rstd_of(ssq, row);
        GAS f32x4* orow = (GAS f32x4*)(out + (size_t)row * D) + lane;
        f32x4 v[8];
#pragma unroll
        for (int j = 0; j < 8; ++j) v[j] = orow[64 * j];
#pragma unroll
        for (int j = 0; j < 8; ++j) orow[64 * j] = v[j] * rs * g[j];
    }
}

#define ONLINE_STEP(s_, vw_) do { const float mn_ = fmaxf(m, (s_)); const float a_ = __builtin_amdgcn_exp2f(m - mn_), p_ = __builtin_amdgcn_exp2f((s_) - mn_); \
        l = l * a_ + p_; o0 = o0 * a_ + p_ * bf_lo(vw_); o1 = o1 * a_ + p_ * bf_hi(vw_); m = mn_; } while (0)
__device__ __forceinline__ void attn_ab_ref(const bf16* proj, bf16* mixed, const float* t5, const float* sink, int gw, int NGW, int lane) {
    for (int u = gw; u < M * 4; u += NGW) {
        const int t = u >> 2, hs = u & 3; int T, sbase; seq_of(t, T, sbase); const int tl = t - sbase;
        float m = -1e30f, l = 0.f, o0 = 0.f, o1 = 0.f;
        for (int g = 0; g < 3; ++g) {
            const int sh = 2 * g, d = 1 << sh;
            const unsigned qw = ((const unsigned*)(proj + (size_t)t * NPROJ + g * 1536 + hs * 128))[lane];
            const float q0 = bf_lo(qw) * (SM_SCALE * LOG2E), q1 = bf_hi(qw) * (SM_SCALE * LOG2E);
            int jlo = -(tl >> sh), jhi = (T - 1 - tl) >> sh; jlo = jlo < -64 ? -64 : jlo; jhi = jhi > 64 ? 64 : jhi;
            const float* tcol = t5 + g * 4 + hs;
            const bf16* kbase = proj + (size_t)t * NPROJ + g * 1536 + 512 + hs * 128;
#pragma unroll 4
            for (int j = jlo; j <= jhi; ++j) {
                const unsigned* kp = (const unsigned*)(kbase + (ptrdiff_t)(d * j) * NPROJ);
                const unsigned kw = kp[lane], vw = kp[256 + lane];
                const float s = wave_sum(q0 * bf_lo(kw) + q1 * bf_hi(kw)) + tcol[t5b(d * j) * 20] * LOG2E;
                ONLINE_STEP(s, vw);
            }
        }
        const float inv = 1.0f / l;
        ((unsigned*)(mixed + (size_t)t * 1536 + hs * 128))[lane] = pk2(o0 * inv, o1 * inv);
    }
    for (int u = gw; u < M * 8; u += NGW) {
        const int t = u >> 3, h = u & 7, kvh = h >> 2; int T, sbase; seq_of(t, T, sbase); const int tl = t - sbase;
        float m = sink[h] * LOG2E, l = 1.f, o0 = 0.f, o1 = 0.f;
        const unsigned qw = ((const unsigned*)(proj + (size_t)t * NPROJ + 4608 + h * 128))[lane];
        const float q0 = bf_lo(qw) * (SM_SCALE * LOG2E), q1 = bf_hi(qw) * (SM_SCALE * LOG2E);
        int jlo = -tl, jhi = T - 1 - tl; jlo = jlo < -128 ? -128 : jlo; jhi = jhi > 128 ? 128 : jhi;
        const float* tcol = t5 + 12 + h;
        const bf16* kbase = proj + (size_t)t * NPROJ + 4608 + 1024 + kvh * 128;
#pragma unroll 4
        for (int j = jlo; j <= jhi; ++j) {
            const unsigned* kp = (const unsigned*)(kbase + (ptrdiff_t)j * NPROJ);
            const unsigned kw = kp[lane], vw = kp[128 + lane];
            const float s = wave_sum(q0 * bf_lo(kw) + q1 * bf_hi(kw)) + tcol[t5b(j) * 20] * LOG2E;
            ONLINE_STEP(s, vw);
        }
        const float inv = 1.0f / l;
        ((unsigned*)(mixed + (size_t)t * 1536 + 512 + h * 128))[lane] = pk2(o0 * inv, o1 * inv);
    }
}
__device__ __forceinline__ void attn_c_ref(const bf16* proj, bf16* mixed, const float* rpb, int gw, int NGW, int lane) {
    for (int u = gw; u < M * 16; u += NGW) {
        const int t = u >> 4, h = u & 15; int T, sbase; seq_of(t, T, sbase); const int tl = t - sbase;
        const int R = tl >> 6, c = tl & 63, rows = T >> 6;
        int rs = R - 4; rs = rs < 0 ? 0 : rs; rs = rs > rows - 8 ? rows - 8 : rs;
        int cs = c - 8; cs = cs < 0 ? 0 : cs; cs = cs > 48 ? 48 : cs;
        float m = -1e30f, l = 0.f, o0 = 0.f, o1 = 0.f;
        const unsigned qw = ((const unsigned*)(proj + (size_t)t * NPROJ + h * 128))[lane];
        const float q0 = bf_lo(qw) * (SM_SCALE * LOG2E), q1 = bf_hi(qw) * (SM_SCALE * LOG2E);
        const float* rp = rpb + h * 15 * 31;
#pragma unroll 4
        for (int kk = 0; kk < 128; ++kk) {
            const int kr = rs + (kk >> 4), kc = cs + (kk & 15);
            const unsigned* kp = (const unsigned*)(proj + (size_t)(sbase + kr * 64 + kc) * NPROJ + 2048 + h * 128);
            const unsigned kw = kp[lane], vw = kp[1024 + lane];
            const float s = wave_sum(q0 * bf_lo(kw) + q1 * bf_hi(kw)) + rp[(kr - R + 7) * 31 + (kc - c + 15)] * LOG2E;
            ONLINE_STEP(s, vw);
        }
        const float inv = 1.0f / l;
        ((unsigned*)(mixed + (size_t)t * 2048 + h * 128))[lane] = pk2(o0 * inv, o1 * inv);
    }
}

struct Args { const float* in[15]; float* out; unsigned char* ws; int ph_lo, ph_hi; };
static_assert(sizeof(Args) == 17 * 8 + 8, "Args has no holes");
__global__ void __launch_bounds__(NWAVES * 64, 2) enc_fwd(Args args) {
    extern __shared__ __attribute__((aligned(16))) unsigned char lds_raw[];
    LAS unsigned char* lds = (LAS unsigned char*)lds_raw;
    volatile LAS unsigned* MISC = (volatile LAS unsigned*)(lds + MISC_OFF);
    const int tid = threadIdx.x, lane = tid & 63, wave = __builtin_amdgcn_readfirstlane(tid >> 6);
    const int G = gridDim.x, gw = blockIdx.x * NWAVES + wave, NGW = G * NWAVES;
    unsigned char* ws = args.ws;
    gu32* ctl = (gu32*)(ws + WS_CTL);
    float* X = args.out;
    bf16* XB = (bf16*)(ws + WS_XB); bf16* MIX = (bf16*)(ws + WS_MIX); bf16* PROJ = (bf16*)(ws + WS_PROJ);
    pg8::u64* SSQ = (pg8::u64*)(ws + WS_SSQ);
    for (int u = tid; u < (LDS_BYTES - LDSCTL_OFF) / 4; u += NWAVES * 64) ((LAS unsigned*)(lds + LDSCTL_OFF))[u] = 0u;
    __syncthreads();
    XcdBarrier bar; bar.bar = (unsigned*)(ctl + CW_BAR); bar.x = 0; bar.st = nullptr;
    if (!PER_PHASE_LAUNCH) bar = xcd_barrier_post((unsigned*)(ctl + CW_BAR), MISC + 8);
    const int lo = args.ph_lo, hi = args.ph_hi;
#define IN(k) (lo <= (k) && (k) < hi)
#define SEAM(k) do { if (!PER_PHASE_LAUNCH && IN(k) && IN((k) + 1)) xcd_barrier(bar); } while (0)
    LAS float* scr = (LAS float*)(lds + RING_OFF + wave * 16384);

    if (IN(0)) {
        prologue_rows(args.in[0], args.in[1], X, XB, SSQ, gw, NGW, lane);
        cvt_win(args.in, ws, 0, scr, gw, NGW, lane);
        cvt_rest(args.in, ws, 0, scr, gw, NGW, lane);
    }
    SEAM(0);
    { constexpr int L = 0;
        const int pb = 1 + 5 * L;
        const int ko = (L & 1) ? 2048 : 1536;
        if (IN(pb)) {
            pg8::Gemm g{XB, (const bf16*)(ws + WS_WIN), M, NPROJ, D}; pg8::StaticOrder S; S.init(M, NPROJ, G, (int)blockIdx.x);
            pg8::EpiProj E{PROJ, NPROJ, SSQ + (size_t)(2 * L) * M};
            pg8::gemm_phase<pg8::EpiProj, pg8::StaticOrder, true, true>(lds + RING_OFF, g, S, E);
        }
        SEAM(pb);
        if (IN(pb + 1)) {
            if (L >= 1) cvt_rest(args.in, ws, L, scr, gw, NGW, lane);
            if (L + 1 < DEPTH) cvt_win(args.in, ws, L + 1, scr, gw, NGW, lane);
            if (L & 1) attn_c_ref(PROJ, MIX, args.in[7] + (size_t)(L >> 1) * 16 * 15 * 31, gw, NGW, lane);
            else attn_ab_ref(PROJ, MIX, args.in[8], args.in[4] + (size_t)(L >> 1) * 8, gw, NGW, lane);
        }
        SEAM(pb + 1);
        if (IN(pb + 2)) {
            pg8::Gemm g{MIX, (const bf16*)(ws + WS_WOUT), M, D, ko}; pg8::StaticOrder S; S.init(M, D, G, (int)blockIdx.x);
            pg8::EpiResid E{X, XB, SSQ + (size_t)(2 * L + 1) * M, D};
            pg8::gemm_phase<pg8::EpiResid, pg8::StaticOrder, true, true>(lds + RING_OFF, g, S, E);
        }
        SEAM(pb + 2);
        if (IN(pb + 3)) {
            pg8::Gemm g{XB, (const bf16*)(ws + WS_WGU), M, NGU, D}; pg8::StaticOrder S; S.init(M, NGU, G, (int)blockIdx.x);
            pg8::EpiGateUp E{PROJ, FF, SSQ + (size_t)(2 * L + 1) * M};
            pg8::gemm_phase<pg8::EpiGateUp, pg8::StaticOrder, true, true>(lds + RING_OFF, g, S, E);
        }
        SEAM(pb + 3);
        if (IN(pb + 4)) {
            pg8::Gemm g{PROJ, (const bf16*)(ws + WS_WDN), M, D, FF}; pg8::StaticOrder S; S.init(M, D, G, (int)blockIdx.x);
            pg8::EpiResid E{X, XB, SSQ + (size_t)(2 * L + 2) * M, D};
            pg8::gemm_phase<pg8::EpiResid, pg8::StaticOrder, true, true>(lds + RING_OFF, g, S, E);
        }
        SEAM(pb + 4);
    }
    { constexpr int L = 1;
        const int pb = 1 + 5 * L;
        const int ko = (L & 1) ? 2048 : 1536;
        if (IN(pb)) {
            pg8::Gemm g{XB, (const bf16*)(ws + WS_WIN), M, NPROJ, D}; pg8::StaticOrder S; S.init(M, NPROJ, G, (int)blockIdx.x);
            pg8::EpiProj E{PROJ, NPROJ, SSQ + (size_t)(2 * L) * M};
            pg8::gemm_phase<pg8::EpiProj, pg8::StaticOrder, true, true>(lds + RING_OFF, g, S, E);
        }
        SEAM(pb);
        if (IN(pb + 1)) {
            if (L >= 1) cvt_rest(args.in, ws, L, scr, gw, NGW, lane);
            if (L + 1 < DEPTH) cvt_win(args.in, ws, L + 1, scr, gw, NGW, lane);
            if (L & 1) attn_c_ref(PROJ, MIX, args.in[7] + (size_t)(L >> 1) * 16 * 15 * 31, gw, NGW, lane);
            else attn_ab_ref(PROJ, MIX, args.in[8], args.in[4] + (size_t)(L >> 1) * 8, gw, NGW, lane);
        }
        SEAM(pb + 1);
        if (IN(pb + 2)) {
            pg8::Gemm g{MIX, (const bf16*)(ws + WS_WOUT), M, D, ko}; pg8::StaticOrder S; S.init(M, D, G, (int)blockIdx.x);
            pg8::EpiResid E{X, XB, SSQ + (size_t)(2 * L + 1) * M, D};
            pg8::gemm_phase<pg8::EpiResid, pg8::StaticOrder, true, true>(lds + RING_OFF, g, S, E);
        }
        SEAM(pb + 2);
        if (IN(pb + 3)) {
            pg8::Gemm g{XB, (const bf16*)(ws + WS_WGU), M, NGU, D}; pg8::StaticOrder S; S.init(M, NGU, G, (int)blockIdx.x);
            pg8::EpiGateUp E{PROJ, FF, SSQ + (size_t)(2 * L + 1) * M};
            pg8::gemm_phase<pg8::EpiGateUp, pg8::StaticOrder, true, true>(lds + RING_OFF, g, S, E);
        }
        SEAM(pb + 3);
        if (IN(pb + 4)) {
            pg8::Gemm g{PROJ, (const bf16*)(ws + WS_WDN), M, D, FF}; pg8::StaticOrder S; S.init(M, D, G, (int)blockIdx.x);
            pg8::EpiResid E{X, XB, SSQ + (size_t)(2 * L + 2) * M, D};
            pg8::gemm_phase<pg8::EpiResid, pg8::StaticOrder, true, true>(lds + RING_OFF, g, S, E);
        }
        SEAM(pb + 4);
    }
    { constexpr int L = 2;
        const int pb = 1 + 5 * L;
        const int ko = (L & 1) ? 2048 : 1536;
        if (IN(pb)) {
            pg8::Gemm g{XB, (const bf16*)(ws + WS_WIN), M, NPROJ, D}; pg8::StaticOrder S; S.init(M, NPROJ, G, (int)blockIdx.x);
            pg8::EpiProj E{PROJ, NPROJ, SSQ + (size_t)(2 * L) * M};
            pg8::gemm_phase<pg8::EpiProj, pg8::StaticOrder, true, true>(lds + RING_OFF, g, S, E);
        }
        SEAM(pb);
        if (IN(pb + 1)) {
            if (L >= 1) cvt_rest(args.in, ws, L, scr, gw, NGW, lane);
            if (L + 1 < DEPTH) cvt_win(args.in, ws, L + 1, scr, gw, NGW, lane);
            if (L & 1) attn_c_ref(PROJ, MIX, args.in[7] + (size_t)(L >> 1) * 16 * 15 * 31, gw, NGW, lane);
            else attn_ab_ref(PROJ, MIX, args.in[8], args.in[4] + (size_t)(L >> 1) * 8, gw, NGW, lane);
        }
        SEAM(pb + 1);
        if (IN(pb + 2)) {
            pg8::Gemm g{MIX, (const bf16*)(ws + WS_WOUT), M, D, ko}; pg8::StaticOrder S; S.init(M, D, G, (int)blockIdx.x);
            pg8::EpiResid E{X, XB, SSQ + (size_t)(2 * L + 1) * M, D};
            pg8::gemm_phase<pg8::EpiResid, pg8::StaticOrder, true, true>(lds + RING_OFF, g, S, E);
        }
        SEAM(pb + 2);
        if (IN(pb + 3)) {
            pg8::Gemm g{XB, (const bf16*)(ws + WS_WGU), M, NGU, D}; pg8::StaticOrder S; S.init(M, NGU, G, (int)blockIdx.x);
            pg8::EpiGateUp E{PROJ, FF, SSQ + (size_t)(2 * L + 1) * M};
            pg8::gemm_phase<pg8::EpiGateUp, pg8::StaticOrder, true, true>(lds + RING_OFF, g, S, E);
        }
        SEAM(pb + 3);
        if (IN(pb + 4)) {
            pg8::Gemm g{PROJ, (const bf16*)(ws + WS_WDN), M, D, FF}; pg8::StaticOrder S; S.init(M, D, G, (int)blockIdx.x);
            pg8::EpiResid E{X, XB, SSQ + (size_t)(2 * L + 2) * M, D};
            pg8::gemm_phase<pg8::EpiResid, pg8::StaticOrder, true, true>(lds + RING_OFF, g, S, E);
        }
        SEAM(pb + 4);
    }
    { constexpr int L = 3;
        const int pb = 1 + 5 * L;
        const int ko = (L & 1) ? 2048 : 1536;
        if (IN(pb)) {
            pg8::Gemm g{XB, (const bf16*)(ws + WS_WIN), M, NPROJ, D}; pg8::StaticOrder S; S.init(M, NPROJ, G, (int)blockIdx.x);
            pg8::EpiProj E{PROJ, NPROJ, SSQ + (size_t)(2 * L) * M};
            pg8::gemm_phase<pg8::EpiProj, pg8::StaticOrder, true, true>(lds + RING_OFF, g, S, E);
        }
        SEAM(pb);
        if (IN(pb + 1)) {
            if (L >= 1) cvt_rest(args.in, ws, L, scr, gw, NGW, lane);
            if (L + 1 < DEPTH) cvt_win(args.in, ws, L + 1, scr, gw, NGW, lane);
            if (L & 1) attn_c_ref(PROJ, MIX, args.in[7] + (size_t)(L >> 1) * 16 * 15 * 31, gw, NGW, lane);
            else attn_ab_ref(PROJ, MIX, args.in[8], args.in[4] + (size_t)(L >> 1) * 8, gw, NGW, lane);
        }
        SEAM(pb + 1);
        if (IN(pb + 2)) {
            pg8::Gemm g{MIX, (const bf16*)(ws + WS_WOUT), M, D, ko}; pg8::StaticOrder S; S.init(M, D, G, (int)blockIdx.x);
            pg8::EpiResid E{X, XB, SSQ + (size_t)(2 * L + 1) * M, D};
            pg8::gemm_phase<pg8::EpiResid, pg8::StaticOrder, true, true>(lds + RING_OFF, g, S, E);
        }
        SEAM(pb + 2);
        if (IN(pb + 3)) {
            pg8::Gemm g{XB, (const bf16*)(ws + WS_WGU), M, NGU, D}; pg8::StaticOrder S; S.init(M, NGU, G, (int)blockIdx.x);
            pg8::EpiGateUp E{PROJ, FF, SSQ + (size_t)(2 * L + 1) * M};
            pg8::gemm_phase<pg8::EpiGateUp, pg8::StaticOrder, true, true>(lds + RING_OFF, g, S, E);
        }
        SEAM(pb + 3);
        if (IN(pb + 4)) {
            pg8::Gemm g{PROJ, (const bf16*)(ws + WS_WDN), M, D, FF}; pg8::StaticOrder S; S.init(M, D, G, (int)blockIdx.x);
            pg8::EpiResid E{X, XB, SSQ + (size_t)(2 * L + 2) * M, D};
            pg8::gemm_phase<pg8::EpiResid, pg8::StaticOrder, true, true>(lds + RING_OFF, g, S, E);
        }
        SEAM(pb + 4);
    }
    if (IN(N_PHASES - 1)) final_norm(X, SSQ + (size_t)8 * M, args.in[14], gw, NGW, lane);
#undef IN
#undef SEAM
}

extern "C" void kernel_launch(void* const* d_in, const int* in_sizes, int n_in, void* d_out, int out_size, void* d_ws, size_t ws_size, hipStream_t stream) {
    static int grid = 0;
    if (grid == 0) {
        if (n_in != 15 || in_sizes[0] != M_PROMPT * D || in_sizes[1] != M_SAMPLE * D || out_size != M * D || ws_size < WS_END) {
            fprintf(stderr, "kernel_launch: unexpected shapes / workspace (n_in %d, out %d, ws %zu, need %zu); nothing launched\n", n_in, out_size, ws_size, (size_t)WS_END); grid = -1; return; }
        int dev = 0, cus = 0, per_cu = 0;
        if (hipGetDevice(&dev) != hipSuccess || hipDeviceGetAttribute(&cus, hipDeviceAttributeMultiprocessorCount, dev) != hipSuccess) { fprintf(stderr, "kernel_launch: device query failed\n"); grid = -1; return; }
        if (hipFuncSetAttribute((const void*)enc_fwd, hipFuncAttributeMaxDynamicSharedMemorySize, LDS_BYTES) != hipSuccess) { fprintf(stderr, "kernel_launch: hipFuncSetAttribute failed\n"); grid = -1; return; }
        if (hipOccupancyMaxActiveBlocksPerMultiprocessor(&per_cu, (const void*)enc_fwd, NWAVES * 64, LDS_BYTES) != hipSuccess || per_cu < 1) {
            fprintf(stderr, "kernel_launch: occupancy query reports %d workgroups per CU; nothing launched\n", per_cu); (void)hipGetLastError(); grid = -1; return; }
        grid = cus;
    }
    if (grid < 0) return;
    if (hipMemsetAsync((char*)d_ws + WS_CTL, 0, CTL_ZERO_BYTES, stream) != hipSuccess) { fprintf(stderr, "kernel_launch: hipMemsetAsync failed\n"); return; }
    Args a{};
    for (int i = 0; i < 15; ++i) a.in[i] = (const float*)d_in[i];
    a.out = (float*)d_out; a.ws = (unsigned char*)d_ws;
    if (PER_PHASE_LAUNCH) {
        for (int p = 0; p < N_PHASES; ++p) { a.ph_lo = p; a.ph_hi = p + 1; hipLaunchKernelGGL(enc_fwd, dim3(grid), dim3(NWAVES * 64), LDS_BYTES, stream, a); }
    } else {
        a.ph_lo = 0; a.ph_hi = N_PHASES;
        hipLaunchKernelGGL(enc_fwd, dim3(grid), dim3(NWAVES * 64), LDS_BYTES, stream, a);
    }
    const hipError_t le = hipPeekAtLastError();
    if (le != hipSuccess) fprintf(stderr, "kernel_launch: launch failed: %s\n", hipGetErrorName(le));
}
```

```cpp
#ifndef GEMM_SERPENTINE
#define GEMM_SERPENTINE 0
#endif
#ifndef FUSE_FINAL
#define FUSE_FINAL 1
#endif
#ifndef NAP_L0
#define NAP_L0 0
#endif
#ifndef PROJ_HM
#define PROJ_HM 1
#endif
#ifndef ATT_FIRST
#define ATT_FIRST 1
#endif
#ifndef C_RECENT
#define C_RECENT 1
#endif
#ifndef PART_HM
#define PART_HM 1
#endif
#ifndef PROBE_ATOM
#define PROBE_ATOM 1
#endif
#ifndef P0_BURN
#define P0_BURN 0
#endif
#ifndef ATT_A_XPF
#define ATT_A_XPF 0
#endif
#ifndef EPI_NT_STORES
#define EPI_NT_STORES 0
#endif
#include <hip/hip_runtime.h>
#include <cstdio>
#include <cstdint>
namespace pg8 {
#define PG8_LAS __attribute__((address_space(3)))
typedef unsigned short bf16_t;
typedef short bf16x8 __attribute__((ext_vector_type(8)));
typedef float f32x4 __attribute__((ext_vector_type(4)));
typedef unsigned u32x4 __attribute__((ext_vector_type(4)));
constexpr int BM = 256, BK = 64, HALF = 128, HTB = HALF * BK * 2  , STAGE_BYTES = 8 * HTB, NXCD = 8, WGM = 8;

__host__ __device__ __forceinline__ int lds_byte(int r, int c) { const int st = (r >> 4) * 2 + (c >> 5), rr = r & 15, cc = c & 31, ob = rr * 64 + cc * 2; return st * 1024 + (ob ^ (((ob >> 9) & 1) << 5)); }
__host__ __device__ __forceinline__ void stage_rc(int b, int& R, int& C) { const int st = b / 1024, sb = b % 1024, swz = sb ^ (((sb >> 9) & 1) << 5); R = (st >> 1) * 16 + swz / 64; C = (st & 1) * 32 + (swz % 64) / 2; }
__host__ __device__ __forceinline__ int perm32(int rho) { const int n = rho >> 4, i = rho & 15; return 8 * (i >> 2) + 4 * n + (i & 3); }

struct Unit { int pm, pn; };
struct Gemm { const bf16_t* A; const bf16_t* Bt; int M, N, K; };

struct StaticOrder {
    int nM, nN, nwg, G, c, wgm, i0 = 0, i1 = 1 << 30, rev = 0;
    __host__ __device__ void init(int M, int N, int G_, int c_, int wgm_ = WGM) { nM = M / BM; nN = N / BM; nwg = nM * nN; G = G_; c = c_; wgm = wgm_; }
    __host__ __device__ bool next(int i, Unit& u) const {
        if (i + i0 >= i1) return false;
        const long L = (long)(i + i0) * G + c; if (L >= nwg) return false;
        int wgid = (int)L; { const int q = nwg / NXCD, r = nwg % NXCD, xcd = wgid % NXCD; int off = wgid / NXCD; if (rev && r == 0) off = ((q - 1 - off) & ~31) | (off & 31);
            wgid = (xcd < r ? xcd * (q + 1) : r * (q + 1) + (xcd - r) * q) + off; }
        const int nig = wgm * nN, gid = wgid / nig, fm = gid * wgm, gsz = (nM - fm) < wgm ? (nM - fm) : wgm;
        u.pm = fm + ((wgid % nig) % gsz); u.pn = (wgid % nig) / gsz; return true;
    }
    __device__ __forceinline__ void a_ready(const Unit&) const {}
    __device__ __forceinline__ void done(const Unit&) const {}
};

__device__ __forceinline__ unsigned cvt_pk_bf16(float lo, float hi) { unsigned r; asm volatile("v_cvt_pk_bf16_f32 %0, %1, %2" : "=v"(r) : "v"(lo), "v"(hi)); return r; }
typedef unsigned long long u64;
constexpr float RMS_EPS_F = 1e-6f, SSQ_FIX = 1048576.0f;
struct RowSsq { u64 v[8]; };
__device__ __forceinline__ RowSsq ssq_rows(const u64* ssq, int row0) { RowSsq r;
#pragma unroll
    for (int it = 0; it < 8; ++it) r.v[it] = ssq[row0 + (it >> 2) * HALF + (it & 3) * 16];
    return r; }
__device__ __forceinline__ float u64_to_f32(u64 v) { return (float)(unsigned)(v >> 32) * 4294967296.0f + (float)(unsigned)v; }
__device__ __forceinline__ float rstd_from(u64 v) { return __builtin_amdgcn_rsqf(u64_to_f32(v) * (1.0f / (2048.0f * SSQ_FIX)) + RMS_EPS_F); }
__device__ __forceinline__ float rstd_of(const u64* ssq, int row) { return rstd_from(ssq[row]); }

#if EPI_NT_STORES
#define EPI_STORE16(p, v) __builtin_nontemporal_store((v), (u32x4*)(p))
#else
#define EPI_STORE16(p, v) (*(u32x4*)(p) = (v))
#endif
struct EpiProj {
    static constexpr bool PERM = true, AFTER_DRAIN = false;
    bf16_t* O; int ldc; const u64* ssq; int permg;
    typedef RowSsq Pre;
    __device__ __forceinline__ Pre prefetch(const Unit& u, int wr, int, int fr, int) const { return ssq_rows(ssq, u.pm * BM + wr * 64 + fr); }
    __device__ __forceinline__ void operator()(const f32x4 (&acc)[2][2][4][2], const Unit& u, int wr, int wc, int fr, int fq, const Pre& pre) const {
        const int row0 = u.pm * BM + wr * 64 + fr, col0 = u.pn * BM + wc * 32 + 8 * fq;
        const int r256_ = u.pm * BM, ldm_ = 49152;
        const int T_ = r256_ < 16384 ? 4096 : 8192, sb_ = r256_ < 16384 ? (r256_ & ~4095) : 16384 + ((r256_ - 16384) & ~8191);
        (void)T_; (void)sb_; (void)ldm_; (void)col0;
        float rsv[8];
#pragma unroll
        for (int it = 0; it < 8; ++it) rsv[it] = rstd_from(pre.v[it]);
#pragma unroll
        for (int ai = 0; ai < 2; ++ai)
#pragma unroll
            for (int m = 0; m < 4; ++m) { const int row = row0 + ai * HALF + m * 16; const float rs = rsv[ai * 4 + m];
#if PROJ_HM
                int rowq = row;
                if (u.pn < 6 * permg) { const int sh = 2 * (u.pn / 6), tl = row - sb_; rowq = sb_ + (tl & ((1 << sh) - 1)) * (T_ >> sh) + (tl >> sh); }
                bf16_t* rowp = O + ((size_t)(u.pn * 2) * (size_t)ldm_ + rowq) * 128 + wc * 32 + 8 * fq; const size_t bjs = (size_t)ldm_ * 128;
#else
                bf16_t* rowp = O + (size_t)row * ldc + col0; const size_t bjs = HALF;
#endif
#pragma unroll
                for (int bj = 0; bj < 2; ++bj) { const f32x4 v0 = acc[ai][bj][m][0] * rs, v1 = acc[ai][bj][m][1] * rs;
                    u32x4 w; w.x = cvt_pk_bf16(v0[0], v0[1]); w.y = cvt_pk_bf16(v0[2], v0[3]); w.z = cvt_pk_bf16(v1[0], v1[1]); w.w = cvt_pk_bf16(v1[2], v1[3]);
                    EPI_STORE16(rowp + bj * bjs, w); } }
    }
};
struct EpiResid {
    static constexpr bool PERM = true, AFTER_DRAIN = false;
    bf16_t* XB; u64* ssq_out; int ldc; float scale; bool atom = true;
    static constexpr int NPRE = 2;
    struct Pre { u32x4 x[NPRE][2]; };
    __device__ __forceinline__ Pre prefetch(const Unit& u, int wr, int wc, int fr, int fq) const { Pre P; const int row0 = u.pm * BM + wr * 64 + fr, col0 = u.pn * BM + wc * 32 + 8 * fq;
#pragma unroll
        for (int it = 0; it < NPRE; ++it) { const bf16_t* xp = XB + (size_t)(row0 + (it >> 2) * HALF + (it & 3) * 16) * ldc + col0; P.x[it][0] = *(const u32x4*)(xp); P.x[it][1] = *(const u32x4*)(xp + HALF); }
        return P; }
    __device__ __forceinline__ void operator()(const f32x4 (&acc)[2][2][4][2], const Unit& u, int wr, int wc, int fr, int fq, const Pre& pre) const {
        const int row0 = u.pm * BM + wr * 64 + fr, col0 = u.pn * BM + wc * 32 + 8 * fq;
        constexpr int WIN = 4;
        u32x4 xin[8][2];
#define RES_LOAD(it_) do { const bf16_t* xp_ = XB + (size_t)(row0 + ((it_) >> 2) * HALF + ((it_) & 3) * 16) * ldc + col0; \
            xin[it_][0] = *(const u32x4*)(xp_); xin[it_][1] = *(const u32x4*)(xp_ + HALF); } while (0)
#pragma unroll
        for (int it = 0; it < NPRE; ++it) { xin[it][0] = pre.x[it][0]; xin[it][1] = pre.x[it][1]; }
#pragma unroll
        for (int it = NPRE; it < NPRE + WIN; ++it) RES_LOAD(it);
#pragma unroll
        for (int it = 0; it < 8; ++it) {
            if (it + NPRE + WIN < 8) RES_LOAD(it + NPRE + WIN);
            const int ai = it >> 2, m = it & 3, row = row0 + ai * HALF + m * 16; bf16_t* bp = XB + (size_t)row * ldc + col0; float part = 0.f;
#pragma unroll
            for (int bj = 0; bj < 2; ++bj) { const u32x4 xo = xin[it][bj];
                f32x4 v0, v1;
                v0[0] = __builtin_bit_cast(float, xo.x << 16); v0[1] = __builtin_bit_cast(float, xo.x & 0xffff0000u); v0[2] = __builtin_bit_cast(float, xo.y << 16); v0[3] = __builtin_bit_cast(float, xo.y & 0xffff0000u);
                v1[0] = __builtin_bit_cast(float, xo.z << 16); v1[1] = __builtin_bit_cast(float, xo.z & 0xffff0000u); v1[2] = __builtin_bit_cast(float, xo.w << 16); v1[3] = __builtin_bit_cast(float, xo.w & 0xffff0000u);
                v0 = v0 + acc[ai][bj][m][0] * scale; v1 = v1 + acc[ai][bj][m][1] * scale;
                part += (v0[0] * v0[0] + v0[1] * v0[1]) + (v0[2] * v0[2] + v0[3] * v0[3]) + (v1[0] * v1[0] + v1[1] * v1[1]) + (v1[2] * v1[2] + v1[3] * v1[3]);
                u32x4 w; w.x = cvt_pk_bf16(v0[0], v0[1]); w.y = cvt_pk_bf16(v0[2], v0[3]); w.z = cvt_pk_bf16(v1[0], v1[1]); w.w = cvt_pk_bf16(v1[2], v1[3]);
                *(u32x4*)(bp + bj * HALF) = w; }
            part += __shfl_xor(part, 16); part += __shfl_xor(part, 32);
            if (fq == 0 && atom) atomicAdd(ssq_out + row, (u64)(part * SSQ_FIX));
            asm volatile("" ::: "memory"); }
#undef RES_LOAD
    }
};
struct EpiFinal {
    static constexpr bool PERM = true, AFTER_DRAIN = false;
    const bf16_t* XB; u64* ssq_out; unsigned* cnt; const float* gain; float* out; int ldc;
    static constexpr int NPRE = EpiResid::NPRE;
    typedef EpiResid::Pre Pre;
    __device__ __forceinline__ Pre prefetch(const Unit& u, int wr, int wc, int fr, int fq) const { Pre P; const int row0 = u.pm * BM + wr * 64 + fr, col0 = u.pn * BM + wc * 32 + 8 * fq;
#pragma unroll
        for (int it = 0; it < NPRE; ++it) { const bf16_t* xp = XB + (size_t)(row0 + (it >> 2) * HALF + (it & 3) * 16) * ldc + col0; P.x[it][0] = *(const u32x4*)(xp); P.x[it][1] = *(const u32x4*)(xp + HALF); }
        return P; }
    __device__ __forceinline__ void operator()(const f32x4 (&acc)[2][2][4][2], const Unit& u, int wr, int wc, int fr, int fq, const Pre& pre) const {
        const int row0 = u.pm * BM + wr * 64 + fr, col0 = u.pn * BM + wc * 32 + 8 * fq;
        constexpr int WIN = 4;
        u32x4 xin[8][2]; f32x4 xn[8][2][2]; u64 old[8];
#define RES_LOAD(it_) do { const bf16_t* xp_ = XB + (size_t)(row0 + ((it_) >> 2) * HALF + ((it_) & 3) * 16) * ldc + col0; \
            xin[it_][0] = *(const u32x4*)(xp_); xin[it_][1] = *(const u32x4*)(xp_ + HALF); } while (0)
#pragma unroll
        for (int it = 0; it < NPRE; ++it) { xin[it][0] = pre.x[it][0]; xin[it][1] = pre.x[it][1]; }
#pragma unroll
        for (int it = NPRE; it < NPRE + WIN; ++it) RES_LOAD(it);
#pragma unroll
        for (int it = 0; it < 8; ++it) {
            if (it + NPRE + WIN < 8) RES_LOAD(it + NPRE + WIN);
            const int ai = it >> 2, m = it & 3, row = row0 + ai * HALF + m * 16; float part = 0.f;
#pragma unroll
            for (int bj = 0; bj < 2; ++bj) { const u32x4 xo = xin[it][bj];
                f32x4 v0, v1;
                v0[0] = __builtin_bit_cast(float, xo.x << 16); v0[1] = __builtin_bit_cast(float, xo.x & 0xffff0000u); v0[2] = __builtin_bit_cast(float, xo.y << 16); v0[3] = __builtin_bit_cast(float, xo.y & 0xffff0000u);
                v1[0] = __builtin_bit_cast(float, xo.z << 16); v1[1] = __builtin_bit_cast(float, xo.z & 0xffff0000u); v1[2] = __builtin_bit_cast(float, xo.w << 16); v1[3] = __builtin_bit_cast(float, xo.w & 0xffff0000u);
                v0 = v0 + acc[ai][bj][m][0]; v1 = v1 + acc[ai][bj][m][1];
                part += (v0[0] * v0[0] + v0[1] * v0[1]) + (v0[2] * v0[2] + v0[3] * v0[3]) + (v1[0] * v1[0] + v1[1] * v1[1]) + (v1[2] * v1[2] + v1[3] * v1[3]);
                xn[it][bj][0] = v0; xn[it][bj][1] = v1; }
            part += __shfl_xor(part, 16); part += __shfl_xor(part, 32);
            old[it] = 0;
            if (fq == 0) old[it] = __hip_atomic_fetch_add(ssq_out + row, (u64)(part * SSQ_FIX), __ATOMIC_RELAXED, __HIP_MEMORY_SCOPE_AGENT);
            asm volatile("" ::: "memory"); }
#undef RES_LOAD
        f32x4 gv[2][2];
#pragma unroll
        for (int bj = 0; bj < 2; ++bj) { gv[bj][0] = *(const f32x4*)(gain + col0 + bj * HALF); gv[bj][1] = *(const f32x4*)(gain + col0 + bj * HALF + 4); }
#pragma unroll
        for (int it = 0; it < 8; ++it) asm volatile("" :: "v"(old[it]));
        asm volatile("s_waitcnt vmcnt(0)" ::: "memory");
        unsigned* cw = cnt + u.pm * 64;
        if (__builtin_amdgcn_mbcnt_hi(~0u, __builtin_amdgcn_mbcnt_lo(~0u, 0u)) == 0) __hip_atomic_fetch_add(cw, 1u, __ATOMIC_RELAXED, __HIP_MEMORY_SCOPE_AGENT);
        asm volatile("" ::: "memory");
        for (unsigned spins = 0; __hip_atomic_load(cw, __ATOMIC_RELAXED, __HIP_MEMORY_SCOPE_AGENT) < 64u && spins < (1u << 20); ++spins) __builtin_amdgcn_s_sleep(4);
        asm volatile("" ::: "memory");
        u64 sv[8];
#pragma unroll
        for (int it = 0; it < 8; ++it) sv[it] = __hip_atomic_load(ssq_out + row0 + (it >> 2) * HALF + (it & 3) * 16, __ATOMIC_RELAXED, __HIP_MEMORY_SCOPE_AGENT);
#pragma unroll
        for (int it = 0; it < 8; ++it) { const int row = row0 + (it >> 2) * HALF + (it & 3) * 16; const float rs = rstd_from(sv[it]); float* op = out + (size_t)row * ldc + col0;
#pragma unroll
            for (int bj = 0; bj < 2; ++bj) { *(f32x4*)(op + bj * HALF) = xn[it][bj][0] * rs * gv[bj][0]; *(f32x4*)(op + bj * HALF + 4) = xn[it][bj][1] * rs * gv[bj][1]; } }
    }
};
struct EpiGateUp {
    static constexpr bool PERM = true, AFTER_DRAIN = false;
    bf16_t* O; int ldc; const u64* ssq;
    typedef RowSsq Pre;
    __device__ __forceinline__ Pre prefetch(const Unit& u, int wr, int, int fr, int) const { return ssq_rows(ssq, u.pm * BM + wr * 64 + fr); }
    __device__ __forceinline__ static float silu_mul(float g, float uu) { const float e = __builtin_amdgcn_exp2f(g * -1.4426950408889634f); return g * __builtin_amdgcn_rcpf(1.0f + e) * uu; }
    __device__ __forceinline__ void operator()(const f32x4 (&acc)[2][2][4][2], const Unit& u, int wr, int wc, int fr, int fq, const Pre& pre) const {
        const int row0 = u.pm * BM + wr * 64 + fr, col0 = u.pn * HALF + wc * 32 + 8 * fq;
        float rsv[8];
#pragma unroll
        for (int it = 0; it < 8; ++it) rsv[it] = rstd_from(pre.v[it]);
#pragma unroll
        for (int ai = 0; ai < 2; ++ai)
#pragma unroll
            for (int m = 0; m < 4; ++m) { const int row = row0 + ai * HALF + m * 16; const float rs = rsv[ai * 4 + m];
                const float cexp = rs * -1.4426950408889634f, rs2 = rs * rs;
                const f32x4 ga = acc[ai][0][m][0], gb = acc[ai][0][m][1];
                const f32x4 ta = ga * acc[ai][1][m][0], tb = gb * acc[ai][1][m][1], xa = ga * cexp, xb = gb * cexp;
                f32x4 da, db;
#pragma unroll
                for (int j = 0; j < 4; ++j) { da[j] = __builtin_amdgcn_exp2f(xa[j]); db[j] = __builtin_amdgcn_exp2f(xb[j]); }
                da = da + 1.0f; db = db + 1.0f;
#pragma unroll
                for (int j = 0; j < 4; ++j) { da[j] = __builtin_amdgcn_rcpf(da[j]); db[j] = __builtin_amdgcn_rcpf(db[j]); }
                const f32x4 oa = ta * da * rs2, ob = tb * db * rs2;
                u32x4 w; w.x = cvt_pk_bf16(oa[0], oa[1]); w.y = cvt_pk_bf16(oa[2], oa[3]); w.z = cvt_pk_bf16(ob[0], ob[1]); w.w = cvt_pk_bf16(ob[2], ob[3]);
                EPI_STORE16(O + (size_t)row * ldc + col0, w); }
    }
};

template <class Epi, class Sched, bool ALIGN_EPI = false, bool SP2 = false, int NAP = 0>
__device__ __forceinline__ void gemm_phase(PG8_LAS unsigned char* lds, const Gemm g, const Sched& S, const Epi& E) {
    const int tid = threadIdx.x, wid = __builtin_amdgcn_readfirstlane(tid >> 6), lane = tid & 63, wr = wid >> 2, wc = wid & 3, fr = lane & 15, fq = lane >> 4;
    const int K = g.K, nt = K / BK;
    unsigned voffA[2], voffB[2];
#pragma unroll
    for (int i = 0; i < 2; ++i) { int R, C; stage_rc(tid * 16 + i * 8192, R, C); const int Rb = Epi::PERM ? ((R & ~31) + perm32(R & 31)) : R;
        voffA[i] = (unsigned)(R * K + C) * 2u; voffB[i] = (unsigned)(Rb * K + C) * 2u; }
    constexpr ptrdiff_t KS = BK * 2;
#define PG8_DIR(i_) (GEMM_SERPENTINE && ((i_) & 1))
    const size_t hstep = (size_t)HALF * K * 2;
    const size_t tstep = 2 * hstep;
    const unsigned ldsw = (unsigned)wid * 1024u;
    const int aoff = lds_byte(wr * 64 + fr, fq * 8), boff = lds_byte(wc * 32 + fr, fq * 8);
#define PG8_SA(b, h) (((b) * 2 + (h)) * HTB)
#define PG8_SB(b, h) ((4 + (b) * 2 + (h)) * HTB)
#define PG8_STAGE(bufoff, gbase, voff) do { _Pragma("unroll") for (int _i = 0; _i < 2; ++_i) \
        __builtin_amdgcn_global_load_lds((const unsigned*)((const char*)(gbase) + (voff)[_i]), (PG8_LAS unsigned*)(lds + (bufoff) + ldsw + _i * 8192), 16, 0, 0); } while (0)
#define PG8_LDA(dst, b, h) do { _Pragma("unroll") for (int m = 0; m < 4; ++m) _Pragma("unroll") for (int k = 0; k < 2; ++k) dst[m][k] = *(const PG8_LAS bf16x8*)(lds + PG8_SA(b, h) + aoff + m * 2048 + k * 1024); } while (0)
#define PG8_LDB(dst, b, h) do { _Pragma("unroll") for (int n = 0; n < 2; ++n) _Pragma("unroll") for (int k = 0; k < 2; ++k) dst[n][k] = *(const PG8_LAS bf16x8*)(lds + PG8_SB(b, h) + boff + n * 2048 + k * 1024); } while (0)
#define PG8_MMA(ai, bj, At, Bt) do { __builtin_amdgcn_s_setprio(1); _Pragma("unroll") for (int m = 0; m < 4; ++m) _Pragma("unroll") for (int n = 0; n < 2; ++n) _Pragma("unroll") for (int k = 0; k < 2; ++k) \
        acc[ai][bj][m][n] = __builtin_amdgcn_mfma_f32_16x16x32_bf16(Bt[n][k], At[m][k], acc[ai][bj][m][n], 0, 0, 0); __builtin_amdgcn_s_setprio(0); } while (0)
#define PG8_WAIT_V(n) asm volatile("s_waitcnt vmcnt(" #n ")" ::: "memory")
#define PG8_WAIT_L(n) asm volatile("s_waitcnt lgkmcnt(" #n ")" ::: "memory")
#define PG8_BAR __builtin_amdgcn_s_barrier()
#define PG8_SCHED __builtin_amdgcn_sched_barrier(0)
    Unit cur, nxt; int ui = 0;
    if (!S.next(0, cur)) return;
    f32x4 acc[2][2][4][2];
#pragma unroll
    for (int a = 0; a < 2; ++a)
#pragma unroll
        for (int b = 0; b < 2; ++b)
#pragma unroll
            for (int m = 0; m < 4; ++m)
#pragma unroll
                for (int n = 0; n < 2; ++n) acc[a][b][m][n] = (f32x4){0.f, 0.f, 0.f, 0.f};
    bf16x8 At[4][2], B0[2][2], B1[2][2];
    ptrdiff_t kstep = PG8_DIR(0) ? -KS : KS;
    const char* cA = (const char*)g.A + (size_t)cur.pm * tstep + (PG8_DIR(0) ? (ptrdiff_t)(nt - 1) * KS : 0); const char* cB = (const char*)g.Bt + (size_t)cur.pn * tstep + (PG8_DIR(0) ? (ptrdiff_t)(nt - 1) * KS : 0);
    S.a_ready(cur);
    typename Epi::Pre pre = E.prefetch(cur, wr, wc, fr, fq);
    if constexpr (SP2) {
        PG8_STAGE(PG8_SB(0, 0), cB, voffB); PG8_STAGE(PG8_SB(0, 1), cB + hstep, voffB); PG8_STAGE(PG8_SA(0, 0), cA, voffA); PG8_STAGE(PG8_SA(0, 1), cA + hstep, voffA);
        if (wr == 1) PG8_BAR;
        PG8_WAIT_V(2); PG8_BAR;
        PG8_STAGE(PG8_SB(1, 0), cB + kstep, voffB); PG8_STAGE(PG8_SA(1, 0), cA + kstep, voffA); PG8_STAGE(PG8_SB(1, 1), cB + hstep + kstep, voffB);
        PG8_WAIT_V(6); PG8_BAR;
    } else {
        PG8_STAGE(PG8_SB(0, 0), cB, voffB); PG8_STAGE(PG8_SA(0, 0), cA, voffA); PG8_STAGE(PG8_SB(0, 1), cB + hstep, voffB); PG8_STAGE(PG8_SA(0, 1), cA + hstep, voffA);
        if (wr == 1) PG8_BAR;
        PG8_WAIT_V(4); PG8_BAR;
        PG8_STAGE(PG8_SB(1, 0), cB + kstep, voffB); PG8_STAGE(PG8_SA(1, 0), cA + kstep, voffA); PG8_STAGE(PG8_SB(1, 1), cB + hstep + kstep, voffB);
        PG8_WAIT_V(6); PG8_BAR;
    }
    for (;;) {
        const bool has_next = S.next(ui + 1, nxt);
        const bool ndir = PG8_DIR(ui + 1); const ptrdiff_t nks = has_next ? (ndir ? -KS : KS) : kstep, noff = ndir ? (ptrdiff_t)(nt - 1) * KS : 0;
        const char* nA = has_next ? (const char*)g.A + (size_t)nxt.pm * tstep + noff : cA; const char* nB = has_next ? (const char*)g.Bt + (size_t)nxt.pn * tstep + noff : cB;
        for (int t = 0; t < nt; t += 2) {
            const bool last = (t == nt - 2);
            if constexpr (NAP > 0) __builtin_amdgcn_s_sleep(NAP);
            const char* a1 = cA + (ptrdiff_t)(t + 1) * kstep;
            const char* a2 = last ? nA : cA + (ptrdiff_t)(t + 2) * kstep; const char* b2 = last ? nB : cB + (ptrdiff_t)(t + 2) * kstep;
            const ptrdiff_t ks3 = last ? nks : kstep; const char* a3 = a2 + ks3; const char* b3 = b2 + ks3;
            if (last && has_next) S.a_ready(nxt);
            if constexpr (SP2) {
            PG8_LDB(B0, 0, 0); PG8_LDB(B1, 0, 1); PG8_SCHED; PG8_LDA(At, 0, 0); PG8_STAGE(PG8_SA(1, 1), a1 + hstep, voffA);
            PG8_WAIT_V(8); PG8_WAIT_L(0); PG8_BAR; PG8_MMA(0, 0, At, B0); PG8_MMA(0, 1, At, B1); PG8_BAR; PG8_SCHED;
            PG8_LDA(At, 0, 1); PG8_STAGE(PG8_SB(0, 0), b2, voffB); PG8_STAGE(PG8_SB(0, 1), b2 + hstep, voffB); PG8_STAGE(PG8_SA(0, 0), a2, voffA);
            PG8_WAIT_V(8); PG8_WAIT_L(0); PG8_BAR; PG8_MMA(1, 0, At, B0); PG8_MMA(1, 1, At, B1); PG8_BAR; PG8_SCHED;
            PG8_LDB(B0, 1, 0); PG8_LDB(B1, 1, 1); PG8_SCHED; PG8_LDA(At, 1, 0); PG8_STAGE(PG8_SA(0, 1), a2 + hstep, voffA);
            PG8_WAIT_V(8); PG8_WAIT_L(0); PG8_BAR; PG8_MMA(0, 0, At, B0); PG8_MMA(0, 1, At, B1); PG8_BAR; PG8_SCHED;
            PG8_LDA(At, 1, 1); PG8_STAGE(PG8_SB(1, 0), b3, voffB); PG8_STAGE(PG8_SB(1, 1), b3 + hstep, voffB); PG8_STAGE(PG8_SA(1, 0), a3, voffA);
            PG8_WAIT_V(8); PG8_WAIT_L(0); PG8_BAR; PG8_MMA(1, 0, At, B0); PG8_MMA(1, 1, At, B1); PG8_BAR; PG8_SCHED;
            } else {
            PG8_LDB(B0, 0, 0); PG8_SCHED; PG8_LDA(At, 0, 0); PG8_STAGE(PG8_SA(1, 1), a1 + hstep, voffA);
            PG8_WAIT_L(8); PG8_BAR; PG8_WAIT_L(0); PG8_MMA(0, 0, At, B0); PG8_BAR; PG8_SCHED;
            PG8_LDB(B1, 0, 1); PG8_STAGE(PG8_SB(0, 0), b2, voffB);
            PG8_BAR; PG8_WAIT_L(0); PG8_MMA(0, 1, At, B1); PG8_BAR;
            PG8_LDA(At, 0, 1); PG8_STAGE(PG8_SA(0, 0), a2, voffA);
            PG8_BAR; PG8_WAIT_L(0); PG8_MMA(1, 0, At, B0); PG8_BAR; PG8_SCHED;
            PG8_STAGE(PG8_SB(0, 1), b2 + hstep, voffB);
            PG8_WAIT_V(6); PG8_BAR; PG8_MMA(1, 1, At, B1); PG8_BAR;
            PG8_LDB(B0, 1, 0); PG8_SCHED; PG8_LDA(At, 1, 0); PG8_STAGE(PG8_SA(0, 1), a2 + hstep, voffA);
            PG8_WAIT_L(8); PG8_BAR; PG8_WAIT_L(0); PG8_MMA(0, 0, At, B0); PG8_BAR; PG8_SCHED;
            PG8_LDB(B1, 1, 1); PG8_STAGE(PG8_SB(1, 0), b3, voffB);
            PG8_BAR; PG8_WAIT_L(0); PG8_MMA(0, 1, At, B1); PG8_BAR;
            PG8_LDA(At, 1, 1); PG8_STAGE(PG8_SA(1, 0), a3, voffA);
            PG8_BAR; PG8_WAIT_L(0); PG8_MMA(1, 0, At, B0); PG8_BAR; PG8_SCHED;
            PG8_STAGE(PG8_SB(1, 1), b3 + hstep, voffB);
            PG8_WAIT_V(6); PG8_BAR; PG8_MMA(1, 1, At, B1); PG8_BAR;
            }
        }
        if constexpr (ALIGN_EPI) { if (wr == 0) PG8_BAR; }
        if constexpr (!Epi::AFTER_DRAIN) { E(acc, cur, wr, wc, fr, fq, pre); S.done(cur); }
        if (!has_next) break;
#pragma unroll
        for (int a = 0; a < 2; ++a)
#pragma unroll
            for (int b = 0; b < 2; ++b)
#pragma unroll
                for (int m = 0; m < 4; ++m)
#pragma unroll
                    for (int n = 0; n < 2; ++n) acc[a][b][m][n] = (f32x4){0.f, 0.f, 0.f, 0.f};
        cur = nxt; cA = nA; cB = nB; kstep = nks; ++ui;
        pre = E.prefetch(cur, wr, wc, fr, fq);
        if constexpr (ALIGN_EPI) { if (wr == 1) PG8_BAR; }
    }
    PG8_WAIT_V(0);
    if constexpr (!ALIGN_EPI) { if (wr == 0) PG8_BAR; }
    PG8_BAR;
    if constexpr (Epi::AFTER_DRAIN) { E.fused(acc, cur, wr, wc, fr, fq, lds, wid, lane); S.done(cur); }
#undef PG8_DIR
#undef PG8_SA
#undef PG8_SB
#undef PG8_STAGE
#undef PG8_LDA
#undef PG8_LDB
#undef PG8_MMA
#undef PG8_WAIT_V
#undef PG8_WAIT_L
#undef PG8_BAR
#undef PG8_SCHED
}
}

constexpr int NWAVES = 8;
#ifndef MK_PER_PHASE
#define MK_PER_PHASE 0
#endif
constexpr bool PER_PHASE_LAUNCH = MK_PER_PHASE != 0;
#ifndef ATT_ROWS_PD
#define ATT_ROWS_PD 3
#endif
#ifndef ATT_STATIC_PRIO
#define ATT_STATIC_PRIO 0
#endif
#ifndef ATT_DMA
#define ATT_DMA 1
#endif
#ifndef ATT_A_WG
#define ATT_A_WG 0
#endif
#ifndef ATT_B_WG
#define ATT_B_WG 1
#endif
#ifndef ATT_C_WG
#define ATT_C_WG 1
#endif
#ifndef GEMM_SP2
#define GEMM_SP2 true
#endif
#ifndef GEMM_ALIGN_EPI
#define GEMM_ALIGN_EPI true
#endif
#ifndef DOWN_REV
#define DOWN_REV 0
#endif
#ifndef WGM_RES
#define WGM_RES 4
#endif
#ifndef WGM_WIDE
#define WGM_WIDE 8
#endif

constexpr int D = 2048, FF = 5632, NGU = 2 * FF, NPROJ = 6144, DEPTH = 4;
constexpr int M_PROMPT = 4 * 4096, M_SAMPLE = 4 * 8192, M = M_PROMPT + M_SAMPLE;
constexpr int N_PHASES = 2 + 6 * DEPTH;
constexpr float SM_SCALE = 0.08838834764831845f, LOG2E = 1.4426950408889634f;

constexpr size_t MiB = 1u << 20;
constexpr size_t WS_CTL = 0, CTL_ZERO_BYTES = 5 * MiB;
constexpr size_t WS_LSE = 5 * MiB;
constexpr size_t WS_SSQ = 1 * MiB;
constexpr size_t WS_WIN = 8 * MiB, WS_WOUT = 32 * MiB, WS_WGU = 40 * MiB, WS_WDN = 84 * MiB;
constexpr size_t WS_XB = 108 * MiB;
constexpr size_t WS_MIX = 300 * MiB;
constexpr size_t WS_PROJ = 492 * MiB;
constexpr size_t WS_END = 1068 * MiB;
static_assert(WS_SSQ + 10ull * M * 8 <= WS_LSE && WS_SSQ + 10ull * M * 8 <= CTL_ZERO_BYTES && WS_LSE >= CTL_ZERO_BYTES && WS_LSE + 12ull * M * 4 <= WS_WIN && WS_WIN + (size_t)NPROJ * D * 2 <= WS_WOUT && WS_WOUT + (size_t)D * D * 2 <= WS_WGU && WS_WGU + (size_t)NGU * D * 2 <= WS_WDN &&
              WS_WDN + (size_t)D * FF * 2 <= WS_XB && WS_XB + (size_t)M * D * 2 <= WS_MIX && WS_MIX + (size_t)M * D * 2 <= WS_PROJ && WS_PROJ + (size_t)M * NPROJ * 2 <= WS_END, "d_ws map");
#if PROJ_HM
constexpr int PRS = 128;
#define PSLOT(slot) ((size_t)(slot) * ((size_t)M * 128))
#else
constexpr int PRS = NPROJ;
#define PSLOT(slot) ((size_t)(slot) * 128)
#endif
constexpr int CW_FIN = 65536;
constexpr int CW_BAR = 4096;

constexpr int RING_OFF = 0, RING_BYTES = 131072;
constexpr int LDSCTL_OFF = RING_BYTES, MISC_OFF = LDSCTL_OFF + 320;
constexpr int LDS_BYTES = 163840;
static_assert(MISC_OFF + 128 <= LDS_BYTES, "LDS map");

#define GAS __attribute__((address_space(1)))
#define LAS __attribute__((address_space(3)))
typedef unsigned short bf16;
typedef unsigned v4u __attribute__((ext_vector_type(4)));
typedef unsigned v2u __attribute__((ext_vector_type(2)));
typedef float f32x4 __attribute__((ext_vector_type(4)));
typedef GAS unsigned gu32;
#define RLX_AGENT __ATOMIC_RELAXED, __HIP_MEMORY_SCOPE_AGENT
#define LDS_WAIT() asm volatile("s_waitcnt lgkmcnt(0)" ::: "memory")
#define VM_WAIT() asm volatile("s_waitcnt vmcnt(0)" ::: "memory")
__device__ __forceinline__ unsigned f2bf(float f) { unsigned u = __builtin_bit_cast(unsigned, f); return (u + 0x7fffu + ((u >> 16) & 1u)) >> 16; }
__device__ __forceinline__ unsigned pk2(float lo, float hi) { return f2bf(lo) | (f2bf(hi) << 16); }
__device__ __forceinline__ float bf_lo(unsigned w) { return __builtin_bit_cast(float, w << 16); }
__device__ __forceinline__ float bf_hi(unsigned w) { return __builtin_bit_cast(float, w & 0xffff0000u); }

#define XB_TMO      128
#define XB_XCNT(j)  (256  + 64 * (j))
#define XB_XSUB(j)  (1280 + 64 * (j))
#define XB_XGEN(j)  (2304 + 64 * (j))
#define XB_TOP      3328
#define XB_TOPGEN   3392
#define XCD_BAR_WORDS 3456
#define XB_SPIN_CAP (1u << 18)

__device__ __forceinline__ unsigned xb_ld(unsigned* p)              { return __hip_atomic_load(p, __ATOMIC_RELAXED, __HIP_MEMORY_SCOPE_AGENT); }
__device__ __forceinline__ unsigned xb_add(unsigned* p, unsigned v) { return __hip_atomic_fetch_add(p, v, __ATOMIC_RELAXED, __HIP_MEMORY_SCOPE_AGENT); }
__device__ __forceinline__ unsigned xb_xcc_id() { return (unsigned)__builtin_amdgcn_s_getreg((3 << 11) | 20) & 0xFu; }
#define XB_SPIN(cond, bar) do { unsigned _sp = 0; while (cond) { __builtin_amdgcn_s_sleep(1); \
    if ((++_sp & 255u) == 0u) { if (xb_ld(&(bar)[XB_TMO])) break; if (_sp > XB_SPIN_CAP) { atomicAdd(&(bar)[XB_TMO], 1u); break; } } } } while (0)

struct XcdBarrier {
    unsigned* bar; unsigned x;
    volatile LAS unsigned* st;
};

__device__ __forceinline__ XcdBarrier xcd_barrier_post(unsigned* bar, volatile LAS unsigned* st) {
    XcdBarrier b; b.bar = bar; b.x = xb_xcc_id(); b.st = st;
    if (threadIdx.x == 0) (void)xb_add(&bar[XB_XCNT(b.x)], 1u);
    return b;
}
__device__ __forceinline__ void xcd_barrier_complete(unsigned* bar, unsigned x, unsigned& nloc, unsigned& nx) {
    const unsigned G = gridDim.x * gridDim.y * gridDim.z;
    unsigned sum, cnt, mine, sp = 0u;
    for (;;) {
        sum = 0u; cnt = 0u; mine = 0u;
#pragma unroll
        for (unsigned j = 0; j < 16; ++j) { const unsigned c = xb_ld(&bar[XB_XCNT(j)]); sum += c; cnt += (c > 0u) ? 1u : 0u; mine = (j == x) ? c : mine; }
        if (sum == G) break;
        __builtin_amdgcn_s_sleep(1);
        if ((++sp & 255u) == 0u) { if (xb_ld(&bar[XB_TMO])) break; if (sp > XB_SPIN_CAP) { atomicAdd(&bar[XB_TMO], 1u); break; } }
    }
    nloc = mine > 0u ? mine : 1u; nx = cnt > 0u ? cnt : 1u;
}

__device__ __forceinline__ void xcd_barrier(const XcdBarrier& b) {
    asm volatile("s_waitcnt vmcnt(0)" ::: "memory");
    __syncthreads();
    if (threadIdx.x == 0) {
        unsigned* bar = b.bar;
        __builtin_amdgcn_s_waitcnt(0);
        unsigned nloc = b.st[0], nx = b.st[1];
        if (nloc == 0u) { xcd_barrier_complete(bar, b.x, nloc, nx); b.st[0] = nloc; b.st[1] = nx; }
        const unsigned old = xb_add(&bar[XB_XSUB(b.x)], 1u);
        const unsigned gen = old / nloc;
        if (old + 1u == (gen + 1u) * nloc) {
            __builtin_amdgcn_fence(__ATOMIC_RELEASE, "agent");
            asm volatile("s_waitcnt vmcnt(0)" ::: "memory");
            const unsigned og = xb_add(&bar[XB_TOP], 1u);
            const unsigned tg = og / nx;
            if (og + 1u == (tg + 1u) * nx) xb_add(&bar[XB_TOPGEN], 1u);
            else XB_SPIN(xb_ld(&bar[XB_TOPGEN]) == tg, bar);
            __builtin_amdgcn_fence(__ATOMIC_ACQUIRE, "agent");
            xb_add(&bar[XB_XGEN(b.x)], 1u);
            asm volatile("s_waitcnt vmcnt(0)" ::: "memory");
        } else {
            XB_SPIN(xb_ld(&bar[XB_XGEN(b.x)]) == gen, bar);
            __builtin_amdgcn_fence(__ATOMIC_ACQUIRE, "agent");
            asm volatile("s_waitcnt vmcnt(0)" ::: "memory");
        }
    }
    __syncthreads();
}

__device__ __forceinline__ float wave_sum(float v) {
#pragma unroll
    for (int o = 1; o < 64; o <<= 1) v += __shfl_xor(v, o);
    return v;
}
__device__ __forceinline__ void seq_of(int t, int& T, int& sbase) {
    if (t < M_PROMPT) { T = 4096; sbase = t & ~4095; } else { T = 8192; sbase = M_PROMPT + ((t - M_PROMPT) & ~8191); }
}
__device__ __forceinline__ int t5b(int rel) {
    const int n = rel < 0 ? -rel : rel;
    int b = n;
    if (n >= 8) b = 8 + (n >= 15) + (n >= 27) + (n >= 50) + (n >= 91) + (n >= 166) + (n >= 305) + (n >= 559);
    return b + (rel > 0 ? 16 : 0);
}
__device__ __forceinline__ void cvt_load(float (&v)[32], const float* W, int N, int item, int lane) {
    const int nblk = N / 32, kb = item / nblk, nb = item % nblk, k0 = 64 * kb, n0 = 32 * nb;
    const float* p = W + (size_t)(k0 + (lane >> 5)) * N + n0 + (lane & 31);
#pragma unroll
    for (int i = 0; i < 32; ++i) v[i] = p[(size_t)(2 * i) * N];
}
__device__ __forceinline__ void cvt_store(const float (&v)[32], int K, int N, const float* gain, bf16* WT, int mode, LAS float* scr, int item, int lane) {
    const int nblk = N / 32, kb = item / nblk, nb = item % nblk, k0 = 64 * kb, n0 = 32 * nb;
#pragma unroll
    for (int i = 0; i < 32; ++i) { const int kk = 2 * i + (lane >> 5); const float g = gain ? gain[k0 + kk] : 1.0f; scr[kk * 33 + (lane & 31)] = v[i] * g; }
    LDS_WAIT(); asm volatile("" ::: "memory");
    const int d0 = mode == 0 ? n0 : ((n0 >> 7) * 256 + (n0 & 127) + (mode == 2 ? 128 : 0));
    const int c = lane & 7;
#pragma unroll
    for (int j = 0; j < 4; ++j) { const int n = (lane >> 3) + 8 * j; const LAS float* s = scr + (8 * c) * 33 + n;
        v4u o; o.x = pk2(s[0 * 33], s[1 * 33]); o.y = pk2(s[2 * 33], s[3 * 33]); o.z = pk2(s[4 * 33], s[5 * 33]); o.w = pk2(s[6 * 33], s[7 * 33]);
        *(GAS v4u*)(WT + (size_t)(d0 + n) * K + k0 + 8 * c) = o; }
    LDS_WAIT(); asm volatile("" ::: "memory");
}
__device__ __forceinline__ void cvt_matrix(const float* W, int K, int N, const float* gain, bf16* WT, int mode, LAS float* scr, int gw, int NGW, int lane) {
    const int nitems = (K / 64) * (N / 32);
    float va[32], vb[32];
    int it = gw;
    if (it < nitems) cvt_load(va, W, N, it, lane);
    while (it < nitems) {
        const int n1 = it + NGW; if (n1 < nitems) cvt_load(vb, W, N, n1, lane);
        cvt_store(va, K, N, gain, WT, mode, scr, it, lane);
        if (n1 >= nitems) break;
        const int n2 = n1 + NGW; if (n2 < nitems) cvt_load(va, W, N, n2, lane);
        cvt_store(vb, K, N, gain, WT, mode, scr, n1, lane);
        it = n2;
    }
}
struct LayerW { const float* win; const float* wout; int ko; };
__device__ __forceinline__ LayerW layer_w(const float* const* in, int L) {
    LayerW w; const int j = L >> 1;
    if (L & 1) { w.win = in[5] + (size_t)j * D * NPROJ; w.wout = in[6] + (size_t)j * D * D; w.ko = 2048; }
    else { w.win = in[2] + (size_t)j * D * NPROJ; w.wout = in[3] + (size_t)j * 1536 * D; w.ko = 1536; }
    return w;
}
__device__ __forceinline__ void cvt_set(const float* const* in, unsigned char* ws, int which, int Lw, int Lr, LAS float* scr, int gw, int NGW, int lane) {
    const LayerW ww = layer_w(in, Lw), wr = layer_w(in, Lr);
    int rot = 0;
    for (int mi = (which & 1) ? 0 : 1; mi < ((which & 2) ? 5 : 1); ++mi) {
        const float* W; int K, N, mode; const float* gain; bf16* WT;
        if (mi == 0)      { W = ww.win; K = D; N = NPROJ; gain = in[9] + (size_t)Lw * D; WT = (bf16*)(ws + WS_WIN); mode = 0; }
        else if (mi == 1) { W = wr.wout; K = wr.ko; N = D; gain = nullptr; WT = (bf16*)(ws + WS_WOUT); mode = 0; }
        else if (mi == 2) { W = in[11] + (size_t)Lr * D * FF; K = D; N = FF; gain = in[10] + (size_t)Lr * D; WT = (bf16*)(ws + WS_WGU); mode = 1; }
        else if (mi == 3) { W = in[12] + (size_t)Lr * D * FF; K = D; N = FF; gain = in[10] + (size_t)Lr * D; WT = (bf16*)(ws + WS_WGU); mode = 2; }
        else              { W = in[13] + (size_t)Lr * FF * D; K = FF; N = D; gain = nullptr; WT = (bf16*)(ws + WS_WDN); mode = 0; }
        int gwm = gw - rot; gwm += gwm < 0 ? NGW : 0;
        cvt_matrix(W, K, N, gain, WT, mode, scr, gwm, NGW, lane);
        rot = (rot + (K / 64) * (N / 32)) % NGW;
    }
}
__device__ __forceinline__ void prow_load(f32x4 (&v)[8], const float* xp, const float* xs, int row, int lane) {
    const float* src = row < M_PROMPT ? xp + (size_t)row * D : xs + (size_t)(row - M_PROMPT) * D;
    const GAS f32x4* xr = (const GAS f32x4*)src + 2 * lane;
#pragma unroll
    for (int j = 0; j < 4; ++j) { v[2 * j] = xr[128 * j]; v[2 * j + 1] = xr[128 * j + 1]; }
}
__device__ __forceinline__ void prow_store(const f32x4 (&v)[8], bf16* xb, pg8::u64* ssq0, int row, int lane) {
    float s = 0.f;
#pragma unroll
    for (int j = 0; j < 8; ++j) s += (v[j].x * v[j].x + v[j].y * v[j].y) + (v[j].z * v[j].z + v[j].w * v[j].w);
    s = wave_sum(s);
    GAS v4u* brow = (GAS v4u*)(xb + (size_t)row * D) + lane;
#pragma unroll
    for (int j = 0; j < 4; ++j) { v4u w; w.x = pk2(v[2 * j].x, v[2 * j].y); w.y = pk2(v[2 * j].z, v[2 * j].w); w.z = pk2(v[2 * j + 1].x, v[2 * j + 1].y); w.w = pk2(v[2 * j + 1].z, v[2 * j + 1].w); brow[64 * j] = w; }
    if (lane == 0) ssq0[row] = (pg8::u64)(s * pg8::SSQ_FIX);
}
#if P0_BURN
typedef float burn16 __attribute__((ext_vector_type(16)));
__device__ __forceinline__ void mfma_burn(burn16& acc, const f32x4& a, const f32x4& b) {
#pragma unroll 8
    for (int i = 0; i < P0_BURN; ++i) asm volatile("v_mfma_f32_32x32x16_bf16 %0, %1, %2, %0" : "+v"(acc) : "v"(a), "v"(b));
}
#endif
__device__ __forceinline__ void prologue_rows(const float* xp, const float* xs, bf16* xb, pg8::u64* ssq0, int gw, int NGW, int lane) {
    f32x4 va[8], vb[8];
#if P0_BURN
    burn16 bacc; for (int i = 0; i < 16; ++i) bacc[i] = 0.f;
#endif
    int row = gw;
    if (row < M) prow_load(va, xp, xs, row, lane);
    while (row < M) {
        const int r1 = row + NGW; if (r1 < M) prow_load(vb, xp, xs, r1, lane);
        prow_store(va, xb, ssq0, row, lane);
#if P0_BURN
        mfma_burn(bacc, va[0], va[1]);
#endif
        if (r1 >= M) break;
        const int r2 = r1 + NGW; if (r2 < M) prow_load(va, xp, xs, r2, lane);
        prow_store(vb, xb, ssq0, r1, lane);
#if P0_BURN
        mfma_burn(bacc, vb[0], vb[1]);
#endif
        row = r2;
    }
#if P0_BURN
    asm volatile("" :: "v"(bacc));
#endif
}
__device__ __forceinline__ void frow_load(v4u (&w)[4], float& rs, const bf16* xb, const pg8::u64* ssq, int row, int lane) {
    const GAS v4u* brow = (const GAS v4u*)(xb + (size_t)row * D) + lane;
#pragma unroll
    for (int j = 0; j < 4; ++j) w[j] = brow[64 * j];
    rs = pg8::rstd_of(ssq, row);
}
__device__ __forceinline__ void frow_store(const v4u (&w)[4], float rs, const f32x4 (&g)[8], float* out, int row, int lane) {
    GAS f32x4* orow = (GAS f32x4*)(out + (size_t)row * D) + 2 * lane;
#pragma unroll
    for (int j = 0; j < 4; ++j) {
        f32x4 a = {bf_lo(w[j].x), bf_hi(w[j].x), bf_lo(w[j].y), bf_hi(w[j].y)}, b = {bf_lo(w[j].z), bf_hi(w[j].z), bf_lo(w[j].w), bf_hi(w[j].w)};
        orow[128 * j] = a * rs * g[2 * j]; orow[128 * j + 1] = b * rs * g[2 * j + 1]; }
}
__device__ __forceinline__ void final_norm(float* out, const bf16* xb, const pg8::u64* ssq, const float* gain, int gw, int NGW, int lane) {
    f32x4 g[8];
#pragma unroll
    for (int j = 0; j < 4; ++j) { g[2 * j] = ((const GAS f32x4*)gain)[2 * lane + 128 * j]; g[2 * j + 1] = ((const GAS f32x4*)gain)[2 * lane + 128 * j + 1]; }
    v4u wa[4], wb[4]; float ra = 0.f, rb = 0.f;
    int row = gw;
    if (row < M) frow_load(wa, ra, xb, ssq, row, lane);
    while (row < M) {
        const int r1 = row + NGW; if (r1 < M) frow_load(wb, rb, xb, ssq, r1, lane);
        frow_store(wa, ra, g, out, row, lane);
        if (r1 >= M) break;
        const int r2 = r1 + NGW; if (r2 < M) frow_load(wa, ra, xb, ssq, r2, lane);
        frow_store(wb, rb, g, out, r1, lane);
        row = r2;
    }
}

#define ONLINE_STEP(s_, vw_) do { const float mn_ = fmaxf(m, (s_)); const float a_ = __builtin_amdgcn_exp2f(m - mn_), p_ = __builtin_amdgcn_exp2f((s_) - mn_); \
        l = l * a_ + p_; o0 = o0 * a_ + p_ * bf_lo(vw_); o1 = o1 * a_ + p_ * bf_hi(vw_); m = mn_; } while (0)
__device__ __forceinline__ void attn_ab_ref(const bf16* proj, bf16* mixed, const float* t5, const float* sink, int gw, int NGW, int lane) {
    for (int u = gw; u < M * 4; u += NGW) {
        const int t = u >> 2, hs = u & 3; int T, sbase; seq_of(t, T, sbase); const int tl = t - sbase;
        float m = -1e30f, l = 0.f, o0 = 0.f, o1 = 0.f;
        for (int g = 0; g < 3; ++g) {
            const int sh = 2 * g, d = 1 << sh;
            const unsigned qw = ((const unsigned*)(proj + (size_t)t * NPROJ + g * 1536 + hs * 128))[lane];
            const float q0 = bf_lo(qw) * (SM_SCALE * LOG2E), q1 = bf_hi(qw) * (SM_SCALE * LOG2E);
            int jlo = -(tl >> sh), jhi = (T - 1 - tl) >> sh; jlo = jlo < -64 ? -64 : jlo; jhi = jhi > 64 ? 64 : jhi;
            const float* tcol = t5 + g * 4 + hs;
            const bf16* kbase = proj + (size_t)t * NPROJ + g * 1536 + 512 + hs * 128;
#pragma unroll 4
            for (int j = jlo; j <= jhi; ++j) {
                const unsigned* kp = (const unsigned*)(kbase + (ptrdiff_t)(d * j) * NPROJ);
                const unsigned kw = kp[lane], vw = kp[256 + lane];
                const float s = wave_sum(q0 * bf_lo(kw) + q1 * bf_hi(kw)) + tcol[t5b(d * j) * 20] * LOG2E;
                ONLINE_STEP(s, vw);
            }
        }
        const float inv = 1.0f / l;
        ((unsigned*)(mixed + (size_t)t * 1536 + hs * 128))[lane] = pk2(o0 * inv, o1 * inv);
    }
    for (int u = gw; u < M * 8; u += NGW) {
        const int t = u >> 3, h = u & 7, kvh = h >> 2; int T, sbase; seq_of(t, T, sbase); const int tl = t - sbase;
        float m = sink[h] * LOG2E, l = 1.f, o0 = 0.f, o1 = 0.f;
        const unsigned qw = ((const unsigned*)(proj + (size_t)t * NPROJ + 4608 + h * 128))[lane];
        const float q0 = bf_lo(qw) * (SM_SCALE * LOG2E), q1 = bf_hi(qw) * (SM_SCALE * LOG2E);
        int jlo = -tl, jhi = T - 1 - tl; jlo = jlo < -128 ? -128 : jlo; jhi = jhi > 128 ? 128 : jhi;
        const float* tcol = t5 + 12 + h;
        const bf16* kbase = proj + (size_t)t * NPROJ + 4608 + 1024 + kvh * 128;
#pragma unroll 4
        for (int j = jlo; j <= jhi; ++j) {
            const unsigned* kp = (const unsigned*)(kbase + (ptrdiff_t)j * NPROJ);
            const unsigned kw = kp[lane], vw = kp[128 + lane];
            const float s = wave_sum(q0 * bf_lo(kw) + q1 * bf_hi(kw)) + tcol[t5b(j) * 20] * LOG2E;
            ONLINE_STEP(s, vw);
        }
        const float inv = 1.0f / l;
        ((unsigned*)(mixed + (size_t)t * 1536 + 512 + h * 128))[lane] = pk2(o0 * inv, o1 * inv);
    }
}
__device__ __forceinline__ void attn_c_ref(const bf16* proj, bf16* mixed, const float* rpb, int gw, int NGW, int lane) {
    for (int u = gw; u < M * 16; u += NGW) {
        const int t = u >> 4, h = u & 15; int T, sbase; seq_of(t, T, sbase); const int tl = t - sbase;
        const int R = tl >> 6, c = tl & 63, rows = T >> 6;
        int rs = R - 4; rs = rs < 0 ? 0 : rs; rs = rs > rows - 8 ? rows - 8 : rs;
        int cs = c - 8; cs = cs < 0 ? 0 : cs; cs = cs > 48 ? 48 : cs;
        float m = -1e30f, l = 0.f, o0 = 0.f, o1 = 0.f;
        const unsigned qw = ((const unsigned*)(proj + (size_t)t * NPROJ + h * 128))[lane];
        const float q0 = bf_lo(qw) * (SM_SCALE * LOG2E), q1 = bf_hi(qw) * (SM_SCALE * LOG2E);
        const float* rp = rpb + h * 15 * 31;
#pragma unroll 4
        for (int kk = 0; kk < 128; ++kk) {
            const int kr = rs + (kk >> 4), kc = cs + (kk & 15);
            const unsigned* kp = (const unsigned*)(proj + (size_t)(sbase + kr * 64 + kc) * NPROJ + 2048 + h * 128);
            const unsigned kw = kp[lane], vw = kp[1024 + lane];
            const float s = wave_sum(q0 * bf_lo(kw) + q1 * bf_hi(kw)) + rp[(kr - R + 7) * 31 + (kc - c + 15)] * LOG2E;
            ONLINE_STEP(s, vw);
        }
        const float inv = 1.0f / l;
        ((unsigned*)(mixed + (size_t)t * 2048 + h * 128))[lane] = pk2(o0 * inv, o1 * inv);
    }
}

typedef short bf16x8 __attribute__((ext_vector_type(8)));
typedef short s16x4 __attribute__((ext_vector_type(4)));
typedef float f32x16 __attribute__((ext_vector_type(16)));
typedef float f32x2v __attribute__((ext_vector_type(2)));
typedef __bf16 bf16x2v __attribute__((ext_vector_type(2)));
constexpr int ATT_TILE_BYTES = 8192;
constexpr int LUT_OFF = 129 * 1024 + 256;
constexpr float NEG_INF = -__builtin_inff(), DEFER_THR = 6.0f;
__device__ __forceinline__ unsigned off_a(unsigned row, unsigned ch) { return 2048u * (row >> 3) + 512u * (ch >> 2) + 64u * (row & 7) + 16u * ((ch & 3) ^ ((row >> 2) & 3)); }
__device__ __forceinline__ unsigned cvtpk(float lo, float hi) { f32x2v v = {lo, hi}; bf16x2v b = __builtin_convertvector(v, bf16x2v); return __builtin_bit_cast(unsigned, b); }
__device__ __forceinline__ s16x4 tr_read(const LAS unsigned char* p) { return __builtin_bit_cast(s16x4, __builtin_amdgcn_ds_read_tr16_b64_v4i16((LAS s16x4*)p)); }
__device__ __forceinline__ int crow16(int i) { return (i & 3) + 8 * (i >> 2); }

__device__ __forceinline__ void lut16(float (&b)[16], const LAS float* p) {
#pragma unroll
    for (int i = 0; i < 16; ++i) b[i] = p[crow16(i)];
    asm volatile("" : "+v"(b[0]), "+v"(b[1]), "+v"(b[2]), "+v"(b[3]), "+v"(b[4]), "+v"(b[5]), "+v"(b[6]), "+v"(b[7]), "+v"(b[8]), "+v"(b[9]), "+v"(b[10]), "+v"(b[11]), "+v"(b[12]), "+v"(b[13]), "+v"(b[14]), "+v"(b[15]));
}
struct AttnAcc { f32x16 o[4]; float m, l; };
__device__ __forceinline__ void tile_voff(unsigned (&voff)[8], int tstride, int lane) {
#pragma unroll
    for (int i = 0; i < 8; ++i) voff[i] = (unsigned)(((lane >> 4) + 4 * i) * tstride) * (unsigned)(NPROJ * 2) + 16u * (lane & 15);
}
__device__ __forceinline__ void tile_load(v4u (&r)[8], const bf16* base, int tok0, const unsigned (&voff)[8]) {
    const char* tb = (const char*)(base + (size_t)tok0 * NPROJ);
#pragma unroll
    for (int i = 0; i < 8; ++i) r[i] = *(const GAS v4u*)(tb + voff[i]);
}
__device__ __forceinline__ void tile_store(LAS unsigned char* t, const v4u (&r)[8], int lane) {
#pragma unroll
    for (int i = 0; i < 8; ++i) *(LAS v4u*)(t + off_a((lane >> 4) + 4 * i, lane & 15)) = r[i];
}
__device__ __forceinline__ f32x16 qk_tile(const LAS unsigned char* kt, const bf16x8 (&qf)[8], int lane, int rowoff = 0) {
    f32x16 st;
#pragma unroll
    for (int i = 0; i < 16; ++i) st[i] = 0.f;
    bf16x8 kf[8];
#pragma unroll
    for (int s = 0; s < 8; ++s) kf[s] = *(const LAS bf16x8*)(kt + off_a(rowoff + (lane & 31), 2 * s + (lane >> 5)));
    __builtin_amdgcn_sched_barrier(0);
#pragma unroll
    for (int s = 0; s < 8; ++s) st = __builtin_amdgcn_mfma_f32_32x32x16_bf16(kf[s], qf[s], st, 0, 0, 0);
    return st;
}
template <bool DEFER>
__device__ __forceinline__ void softmax_part(AttnAcc& A, f32x16 x, bf16x8 (&pb)[2], int lane) {
    float mx = x[0];
#pragma unroll
    for (int i = 1; i < 16; ++i) mx = fmaxf(mx, x[i]);
    mx = fmaxf(mx, __shfl_xor(mx, 32));
    if (!DEFER || __builtin_amdgcn_ballot_w64(mx > A.m + DEFER_THR) != 0ull) {
        const float mn = fmaxf(A.m, mx), alpha = __builtin_amdgcn_exp2f(A.m - mn); A.m = mn; A.l = A.l * alpha;
#pragma unroll
        for (int c = 0; c < 4; ++c) A.o[c] = A.o[c] * alpha;
    }
    const float mcur = A.m; float ps = 0.f;
#pragma unroll
    for (int i = 0; i < 16; ++i) { x[i] = __builtin_amdgcn_exp2f(x[i] - mcur); ps += x[i]; }
    A.l += ps;
#pragma unroll
    for (int ks = 0; ks < 2; ++ks) { v4u w; w.x = cvtpk(x[8 * ks], x[8 * ks + 1]); w.y = cvtpk(x[8 * ks + 2], x[8 * ks + 3]); w.z = cvtpk(x[8 * ks + 4], x[8 * ks + 5]); w.w = cvtpk(x[8 * ks + 6], x[8 * ks + 7]);
        pb[ks] = __builtin_bit_cast(bf16x8, w); }
}
__device__ __forceinline__ void pv_part(AttnAcc& A, const bf16x8 (&pb)[2], const LAS unsigned char* vt, int lane, int rowoff = 0) {
    const unsigned h = lane >> 5, blk = (lane >> 4) & 1, q = (lane & 15) >> 2, p = lane & 3;
    bf16x8 va[4][2];
#pragma unroll
    for (int c = 0; c < 4; ++c)
#pragma unroll
        for (int ks = 0; ks < 2; ++ks) {
            const s16x4 lo = tr_read(vt + off_a(rowoff + 16 * ks + 4 * h + q, 4 * c + 2 * blk + (p >> 1)) + 8 * (p & 1));
            const s16x4 hi = tr_read(vt + off_a(rowoff + 16 * ks + 8 + 4 * h + q, 4 * c + 2 * blk + (p >> 1)) + 8 * (p & 1));
            va[c][ks] = __builtin_shufflevector(lo, hi, 0, 1, 2, 3, 4, 5, 6, 7);
        }
    __builtin_amdgcn_sched_barrier(0);
#pragma unroll
    for (int c = 0; c < 4; ++c)
#pragma unroll
        for (int ks = 0; ks < 2; ++ks) A.o[c] = __builtin_amdgcn_mfma_f32_32x32x16_bf16(va[c][ks], pb[ks], A.o[c], 0, 0, 0);
}
template <bool DEFER>
__device__ __forceinline__ void softmax_pv(AttnAcc& A, f32x16 x, const LAS unsigned char* vt, int lane, int rowoff = 0) {
    bf16x8 pb[2]; softmax_part<DEFER>(A, x, pb, lane); pv_part(A, pb, vt, lane, rowoff);
}
__device__ __forceinline__ void acc_init(AttnAcc& A, float m0, float l0) {
#pragma unroll
    for (int c = 0; c < 4; ++c)
#pragma unroll
        for (int i = 0; i < 16; ++i) A.o[c][i] = 0.f;
    A.m = m0; A.l = l0;
}
__device__ __forceinline__ void q_load(bf16x8 (&qf)[8], const bf16* qrow, int lane) {
#pragma unroll
    for (int s = 0; s < 8; ++s) qf[s] = *(const GAS bf16x8*)(qrow + 16 * s + 8 * (lane >> 5));
}
__device__ __forceinline__ void o_store(const AttnAcc& A, float inv, bf16* orow, int lane) {
    const int h = lane >> 5;
#pragma unroll
    for (int c = 0; c < 4; ++c)
#pragma unroll
        for (int g = 0; g < 4; ++g) { v2u w; w.x = cvtpk(A.o[c][4 * g] * inv, A.o[c][4 * g + 1] * inv); w.y = cvtpk(A.o[c][4 * g + 2] * inv, A.o[c][4 * g + 3] * inv);
            *(GAS v2u*)(orow + 32 * c + 8 * g + 4 * h) = w; }
}
__device__ __forceinline__ void o_store_t(const AttnAcc& A, float inv, bf16* obase, int qtok, int pitch, LAS unsigned char* scr, int lane) {
    const int r = lane & 31, h = lane >> 5;
#pragma unroll
    for (int c = 0; c < 4; ++c)
#pragma unroll
        for (int g = 0; g < 4; ++g) { v2u w; w.x = cvtpk(A.o[c][4 * g] * inv, A.o[c][4 * g + 1] * inv); w.y = cvtpk(A.o[c][4 * g + 2] * inv, A.o[c][4 * g + 3] * inv);
            *(LAS v2u*)(scr + off_a(r, 4 * c + g) + 8 * h) = w; }
    asm volatile("s_waitcnt lgkmcnt(0)" ::: "memory");
#pragma unroll
    for (int i = 0; i < 8; ++i) { const int row = (lane >> 4) + 4 * i; const v4u v = *(const LAS v4u*)(scr + off_a(row, lane & 15)); const int tok = __shfl(qtok, row);
        *(GAS v4u*)(obase + (size_t)tok * pitch + 8 * (lane & 15)) = v; }
    asm volatile("s_waitcnt lgkmcnt(0)" ::: "memory");
}
__device__ __forceinline__ int virt_wave(int G, int wave) { const int bx = blockIdx.x; const int vb = (G % 8 == 0) ? (bx % 8) * (G / 8) + bx / 8 : bx; return vb * NWAVES + wave; }
__device__ __forceinline__ void seq_of_block(int gb, int& T, int& sbase, int& b) {
    if (gb < M_PROMPT / 32) { T = 4096; sbase = (gb >> 7) * 4096; b = gb & 127; } else { const int g2 = gb - M_PROMPT / 32; T = 8192; sbase = M_PROMPT + (g2 >> 8) * 8192; b = g2 & 255; }
}

__device__ __forceinline__ void attn_a_mfma(const bf16* proj, bf16* part, float* lse, LAS unsigned char* lds, int G, int wave, int lane) {
    LAS unsigned char* kt = lds + RING_OFF + wave * 16384; LAS unsigned char* vt = kt + ATT_TILE_BYTES;
    const LAS float* lut = (const LAS float*)(lds + LUT_OFF);
    constexpr int U = 12 * (M / 32); const int NGW = G * NWAVES, upw = (U + NGW - 1) / NGW, vw = virt_wave(G, wave);
    const int r = lane & 31, h = lane >> 5;
    for (int k = 0; k < upw; ++k) {
        const int u = k * NGW + vw; if (u >= U) break;
        const int gh = u / (M / 32), gb = u % (M / 32), g = gh >> 2, hs = gh & 3, sh = 2 * g;
        int T, sbase, b; seq_of_block(gb, T, sbase, b);
        const int l32 = (T >> 5) >> sh, rho = b / l32, p0 = 32 * (b % l32), L = 32 * l32, d = 1 << sh;
        const int qtok = sbase + rho + d * (p0 + r);
        bf16x8 qf[8]; q_load(qf, proj + (size_t)qtok * NPROJ + g * 1536 + hs * 128, lane);
        const bf16* kbase = proj + g * 1536 + 512 + hs * 128; const bf16* vbase = kbase + 512;
        const LAS float* lt = lut + (g * 4 + hs) * 129;
        AttnAcc A; acc_init(A, -1e30f, 0.f);
        int tt0 = 0, tt1 = 4;
        while (p0 - 64 + 32 * tt0 < 0) ++tt0;
        while (p0 - 64 + 32 * tt1 >= L) --tt1;
        v4u kr[8], vr[8]; unsigned voff[8]; tile_voff(voff, d, lane);
        tile_load(kr, kbase, sbase + rho + d * (p0 - 64 + 32 * tt0), voff); tile_load(vr, vbase, sbase + rho + d * (p0 - 64 + 32 * tt0), voff);
        for (int tt = tt0; tt <= tt1; ++tt) {
            tile_store(kt, kr, lane); tile_store(vt, vr, lane);
            if (tt < tt1) { const int nk = sbase + rho + d * (p0 - 64 + 32 * (tt + 1)); tile_load(kr, kbase, nk, voff); tile_load(vr, vbase, nk, voff); }
            f32x16 st = qk_tile(kt, qf, lane);
            const int ib = 32 * tt + 4 * h - r;
float bias[16]; lut16(bias, lt + ib);
#pragma unroll
            for (int i = 0; i < 16; ++i) { const int idx = ib + crow16(i); st[i] = ((unsigned)idx <= 128u) ? st[i] * (SM_SCALE * LOG2E) + bias[i] : NEG_INF; }
            softmax_pv<false>(A, st, vt, lane);
        }
        const float lt_ = A.l + __shfl_xor(A.l, 32), inv = 1.0f / lt_;
        o_store(A, inv, part + (size_t)qtok * D + g * 512 + hs * 128, lane);
        if (h == 0) lse[(size_t)qtok * 12 + g * 4 + hs] = A.m + __builtin_amdgcn_logf(lt_);
    }
}
struct MergeRegs { v4u a, b, c; float l0, l1, l2; };
__device__ __forceinline__ void merge_load(MergeRegs& R, const bf16* part, const float* lse, int t, int lane) {
    const int hs = lane >> 4;
    R.l0 = lse[(size_t)t * 12 + hs]; R.l1 = lse[(size_t)t * 12 + 4 + hs]; R.l2 = lse[(size_t)t * 12 + 8 + hs];
#if PART_HM
    int T, sbase; seq_of(t, T, sbase); const int tl = t - sbase, c8 = 8 * (lane & 15);
    const size_t r1 = (size_t)(sbase + (tl & 3) * (T >> 2) + (tl >> 2)), r2 = (size_t)(sbase + (tl & 15) * (T >> 4) + (tl >> 4));
    R.a = *(const GAS v4u*)(part + ((size_t)hs * M + t) * 128 + c8); R.b = *(const GAS v4u*)(part + ((size_t)(4 + hs) * M + r1) * 128 + c8); R.c = *(const GAS v4u*)(part + ((size_t)(8 + hs) * M + r2) * 128 + c8);
#else
    R.a = *(const GAS v4u*)(part + (size_t)t * D + 8 * lane); R.b = *(const GAS v4u*)(part + (size_t)t * D + 512 + 8 * lane); R.c = *(const GAS v4u*)(part + (size_t)t * D + 1024 + 8 * lane);
#endif
}
__device__ __forceinline__ void merge_store(const MergeRegs& R, bf16* mixed, int t, int lane) {
    const float mx = fmaxf(R.l0, fmaxf(R.l1, R.l2)); float w0 = __builtin_amdgcn_exp2f(R.l0 - mx), w1 = __builtin_amdgcn_exp2f(R.l1 - mx), w2 = __builtin_amdgcn_exp2f(R.l2 - mx);
    const float inv = 1.0f / (w0 + w1 + w2); w0 *= inv; w1 *= inv; w2 *= inv;
    v4u o;
#pragma unroll
    for (int j = 0; j < 4; ++j) o[j] = pk2(w0 * bf_lo(R.a[j]) + w1 * bf_lo(R.b[j]) + w2 * bf_lo(R.c[j]), w0 * bf_hi(R.a[j]) + w1 * bf_hi(R.b[j]) + w2 * bf_hi(R.c[j]));
    *(GAS v4u*)(mixed + (size_t)t * 1536 + 8 * lane) = o;
}
__device__ __forceinline__ void merge_a(const bf16* part, const float* lse, bf16* mixed, int gw, int NGW, int lane) {
    MergeRegs ra, rb;
    int t = gw;
    if (t < M) merge_load(ra, part, lse, t, lane);
    while (t < M) {
        const int t1 = t + NGW; if (t1 < M) merge_load(rb, part, lse, t1, lane);
        merge_store(ra, mixed, t, lane);
        if (t1 >= M) break;
        const int t2 = t1 + NGW; if (t2 < M) merge_load(ra, part, lse, t2, lane);
        merge_store(rb, mixed, t1, lane);
        t = t2;
    }
}
__device__ __forceinline__ void attn_b_mfma(const bf16* proj, bf16* mixed, const float* sink, LAS unsigned char* lds, int G, int wave, int lane) {
    LAS unsigned char* kt = lds + RING_OFF + wave * 16384; LAS unsigned char* vt = kt + ATT_TILE_BYTES;
    const LAS float* lut = (const LAS float*)(lds + LUT_OFF) + 12 * 129;
    constexpr int U = 8 * (M / 32); const int NGW = G * NWAVES, upw = (U + NGW - 1) / NGW, vw = virt_wave(G, wave);
    const int r = lane & 31, h = lane >> 5; unsigned voff[8]; tile_voff(voff, 1, lane);
    for (int k = 0; k < upw; ++k) {
        const int u = k * NGW + vw; if (u >= U) break;
        const int hq = u & 3, gb = (u >> 2) % (M / 32), kvh = (u >> 2) / (M / 32), hd = kvh * 4 + hq;
        int T, sbase, b; seq_of_block(gb, T, sbase, b);
        const int t0 = 32 * b, qtok = sbase + t0 + r;
        bf16x8 qf[8]; q_load(qf, proj + (size_t)qtok * NPROJ + 4608 + hd * 128, lane);
        const bf16* kbase = proj + 4608 + 1024 + kvh * 128; const bf16* vbase = kbase + 256;
        const LAS float* lt = lut + hd * 257;
        AttnAcc A; acc_init(A, sink[hd] * LOG2E, h == 0 ? 1.f : 0.f);
        int tt0 = 0, tt1 = 8;
        while (t0 - 128 + 32 * tt0 < 0) ++tt0;
        while (t0 - 128 + 32 * tt1 >= T) --tt1;
        v4u kr[8], vr[8];
        tile_load(kr, kbase, sbase + t0 - 128 + 32 * tt0, voff); tile_load(vr, vbase, sbase + t0 - 128 + 32 * tt0, voff);
        for (int tt = tt0; tt <= tt1; ++tt) {
            tile_store(kt, kr, lane); tile_store(vt, vr, lane);
            if (tt < tt1) { const int nk = sbase + t0 - 128 + 32 * (tt + 1); tile_load(kr, kbase, nk, voff); tile_load(vr, vbase, nk, voff); }
            f32x16 st = qk_tile(kt, qf, lane);
            const int ib = 32 * tt + 4 * h - r;
float bias[16]; lut16(bias, lt + ib);
#pragma unroll
            for (int i = 0; i < 16; ++i) { const int idx = ib + crow16(i); st[i] = ((unsigned)idx <= 256u) ? st[i] * (SM_SCALE * LOG2E) + bias[i] : NEG_INF; }
            softmax_pv<false>(A, st, vt, lane);
        }
        const float inv = 1.0f / (A.l + __shfl_xor(A.l, 32));
        o_store(A, inv, mixed + (size_t)qtok * 1536 + 512 + hd * 128, lane);
    }
}
__device__ __forceinline__ void attn_c_mfma(const bf16* proj, bf16* mixed, LAS unsigned char* lds, int G, int wave, int lane) {
    LAS unsigned char* kt = lds + RING_OFF + wave * 16384; LAS unsigned char* vt = kt + ATT_TILE_BYTES;
    const LAS float* lut = (const LAS float*)(lds + LUT_OFF);
    constexpr int U = 16 * (M / 32); const int NGW = G * NWAVES, upw = (U + NGW - 1) / NGW, vw = virt_wave(G, wave);
    const int r = lane & 31, h = lane >> 5; unsigned voff[8]; tile_voff(voff, 1, lane);
    for (int k = 0; k < upw; ++k) {
        const int u = k * NGW + vw; if (u >= U) break;
        const int hd = u / (M / 32), gbc = u % (M / 32), rp = gbc >> 2, c0 = 16 * (gbc & 3);
        int rows, sbase, R0;
        if (rp < 128) { rows = 64; sbase = (rp >> 5) * 4096; R0 = 2 * (rp & 31); } else { const int r2 = rp - 128; rows = 128; sbase = M_PROMPT + (r2 >> 6) * 8192; R0 = 2 * (r2 & 63); }
        const int Rq = R0 + (r >> 4), cq = c0 + (r & 15), qtok = sbase + Rq * 64 + cq;
        int rsq = Rq - 4; rsq = rsq < 0 ? 0 : (rsq > rows - 8 ? rows - 8 : rsq);
        int csq = cq - 8; csq = csq < 0 ? 0 : (csq > 48 ? 48 : csq);
        int rlo = R0 - 4; rlo = rlo < 0 ? 0 : (rlo > rows - 8 ? rows - 8 : rlo);
        int rhi = R0 - 3; rhi = (rhi < 0 ? 0 : (rhi > rows - 8 ? rows - 8 : rhi)) + 7;
        int kc0 = c0 - 8; kc0 = kc0 < 0 ? 0 : (kc0 > 32 ? 32 : kc0);
        bf16x8 qf[8]; q_load(qf, proj + (size_t)qtok * NPROJ + hd * 128, lane);
        const bf16* kbase = proj + 2048 + hd * 128; const bf16* vbase = kbase + 2048;
        const LAS float* lt = lut + hd * 465;
        AttnAcc A; acc_init(A, -1e30f, 0.f);
        v4u kr[8], vr[8];
        tile_load(kr, kbase, sbase + rlo * 64 + kc0, voff); tile_load(vr, vbase, sbase + rlo * 64 + kc0, voff);
        for (int krow = rlo; krow <= rhi; ++krow) {
            tile_store(kt, kr, lane); tile_store(vt, vr, lane);
            if (krow < rhi) { const int nk = sbase + (krow + 1) * 64 + kc0; tile_load(kr, kbase, nk, voff); tile_load(vr, vbase, nk, voff); }
            f32x16 st = qk_tile(kt, qf, lane);
            const bool rowok = (unsigned)(krow - rsq) < 8u;
            const int cb = kc0 + 4 * h - csq;
            const int ib = (krow - Rq + 7) * 31 + (kc0 + 4 * h - cq + 15);
float bias[16]; lut16(bias, lt + ib);
#pragma unroll
            for (int i = 0; i < 16; ++i) st[i] = (rowok && (unsigned)(cb + crow16(i)) < 16u) ? st[i] * (SM_SCALE * LOG2E) + bias[i] : NEG_INF;
            softmax_pv<false>(A, st, vt, lane);
        }
        const float inv = 1.0f / (A.l + __shfl_xor(A.l, 32));
        o_store(A, inv, mixed + (size_t)qtok * 2048 + hd * 128, lane);
    }
}
__device__ __forceinline__ void lut_fill_ab(const float* t5, LAS unsigned char* lds, int tid) {
    LAS float* lut = (LAS float*)(lds + LUT_OFF);
    for (int i = tid; i < 12 * 129; i += NWAVES * 64) { const int gh = i / 129, rel = i % 129 - 64, g = gh >> 2; lut[i] = t5[t5b(rel * (1 << (2 * g))) * 20 + gh] * LOG2E; }
    for (int i = tid; i < 8 * 257; i += NWAVES * 64) { const int hd = i / 257, rel = i % 257 - 128; lut[12 * 129 + i] = t5[t5b(rel) * 20 + 12 + hd] * LOG2E; }
}
__device__ __forceinline__ void lut_fill_c(const float* rpb, LAS unsigned char* lds, int tid) {
    LAS float* lut = (LAS float*)(lds + LUT_OFF);
    for (int i = tid; i < 16 * 465; i += NWAVES * 64) lut[i] = rpb[i] * LOG2E;
}

constexpr int WGT_BYTES = 16384;
__device__ __forceinline__ int virt_block(int G) { const int bx = blockIdx.x; return (G % 8 == 0) ? (bx % 8) * (G / 8) + bx / 8 : bx; }
__device__ __forceinline__ void seq_of_block256(int blk, int& T, int& sbase, int& b) {
    if (blk < M_PROMPT / 256) { T = 4096; sbase = (blk >> 4) * 4096; b = blk & 15; } else { const int g2 = blk - M_PROMPT / 256; T = 8192; sbase = M_PROMPT + (g2 >> 5) * 8192; b = g2 & 31; }
}
__device__ __forceinline__ void wg_tile_issue(v4u& kr, v4u& vr, const bf16* kbase, const bf16* vbase, int tok0, int tstride, int tid) {
    const size_t off = (size_t)(tok0 + (tid >> 4) * tstride) * PRS + 8 * (tid & 15);
    kr = *(const GAS v4u*)(kbase + off); vr = *(const GAS v4u*)(vbase + off);
}
__device__ __forceinline__ void wg_tile_commit(LAS unsigned char* buf, const v4u& kr, const v4u& vr, int tid) {
    const unsigned o = off_a(tid >> 4, tid & 15);
    *(LAS v4u*)(buf + o) = kr; *(LAS v4u*)(buf + ATT_TILE_BYTES + o) = vr;
}
#define WG_BAR() do { asm volatile("s_waitcnt lgkmcnt(0)" ::: "memory"); __builtin_amdgcn_s_barrier(); asm volatile("" ::: "memory"); } while (0)
template <class Geo>
__device__ __forceinline__ void wg_stream(const Geo& geo, const bf16* kbase, const bf16* vbase, int tstride, AttnAcc& A, const bf16x8 (&qf)[8], LAS unsigned char* tb, int lane, int tid) {
    const int j0 = geo.j0, j1 = geo.j1;
    v4u k0, v0, k1, v1, k2, v2;
    wg_tile_issue(k0, v0, kbase, vbase, geo.tok0(j0), tstride, tid);
    if (j0 + 1 <= j1) wg_tile_issue(k1, v1, kbase, vbase, geo.tok0(j0 + 1), tstride, tid);
    if (j0 + 2 <= j1) wg_tile_issue(k2, v2, kbase, vbase, geo.tok0(j0 + 2), tstride, tid);
    wg_tile_commit(tb + (j0 & 1) * WGT_BYTES, k0, v0, tid);
    WG_BAR();
#define WG_STEP(jj, KI, VI, KC, VC) do { \
        if ((jj) + 3 <= j1) wg_tile_issue(KI, VI, kbase, vbase, geo.tok0((jj) + 3), tstride, tid); \
        if (geo.active(jj)) { const LAS unsigned char* kt_ = tb + ((jj) & 1) * WGT_BYTES; f32x16 st_ = qk_tile(kt_, qf, lane); geo.logits(st_, (jj)); softmax_pv<true>(A, st_, kt_ + ATT_TILE_BYTES, lane); } \
        if ((jj) + 1 <= j1) wg_tile_commit(tb + (((jj) + 1) & 1) * WGT_BYTES, KC, VC, tid); \
        WG_BAR(); } while (0)
    for (int j = j0; j <= j1; j += 3) {
        WG_STEP(j, k0, v0, k1, v1);
        if (j + 1 > j1) break;
        WG_STEP(j + 1, k1, v1, k2, v2);
        if (j + 2 > j1) break;
        WG_STEP(j + 2, k2, v2, k0, v0);
    }
#undef WG_STEP
}
struct GeoA { int j0, j1, wave, tokb, d, ibw; const LAS float* lt;
    __device__ __forceinline__ int tok0(int j) const { return tokb + d * 32 * j; }
    __device__ __forceinline__ bool active(int j) const { return j >= wave && j <= wave + 4; }
    __device__ __forceinline__ void logits(f32x16& st, int j) const { const int ib = 32 * j + ibw;
float bias[16]; lut16(bias, lt + ib);
        if (j - wave >= 1 && j - wave <= 3) {
#pragma unroll
            for (int i = 0; i < 16; ++i) st[i] = st[i] * (SM_SCALE * LOG2E) + bias[i];
        } else {
#pragma unroll
            for (int i = 0; i < 16; ++i) { const int idx = ib + crow16(i); st[i] = ((unsigned)idx <= 128u) ? st[i] * (SM_SCALE * LOG2E) + bias[i] : NEG_INF; }
        } }
};
__device__ __forceinline__ void attn_a_wg(const bf16* proj, bf16* part, float* lse, LAS unsigned char* lds, int G, int wave, int lane, int tid) {
    LAS unsigned char* tb = lds + RING_OFF;
    const LAS float* lut = (const LAS float*)(lds + LUT_OFF);
    constexpr int U = 12 * (M / 256); const int vb = virt_block(G);
    const int r = lane & 31, h = lane >> 5;
    for (int k = 0; ; ++k) {
        const int u = k * G + vb; if (u >= U) break;
        const int gh = u / (M / 256), blk = u % (M / 256), g = gh >> 2, hs = gh & 3, sh = 2 * g, d = 1 << sh;
        int T, sbase, b; seq_of_block256(blk, T, sbase, b);
        const int l256 = (T >> 8) >> sh, rho = b / l256, P0 = 256 * (b % l256), L = 256 * l256;
        const int qtok = sbase + rho + d * (P0 + 32 * wave + r);
#if PROJ_HM
        const int qrow = sbase + rho * L + P0 + 32 * wave + r, ts = 1, tokb = sbase + rho * L + P0 - 64;
        bf16x8 qf[8]; q_load(qf, proj + PSLOT(g * 12 + hs) + (size_t)qrow * PRS, lane);
        const bf16* kbase = proj + PSLOT(g * 12 + 4 + hs); const bf16* vbase = kbase + PSLOT(4);
#else
        const int ts = d, tokb = sbase + rho + d * (P0 - 64);
        bf16x8 qf[8]; q_load(qf, proj + (size_t)qtok * NPROJ + g * 1536 + hs * 128, lane);
        const bf16* kbase = proj + g * 1536 + 512 + hs * 128; const bf16* vbase = kbase + 512;
#endif
        AttnAcc A; acc_init(A, -1e30f, 0.f);
        GeoA geo; geo.j0 = 0; geo.j1 = 11;
        while (P0 - 64 + 32 * geo.j0 < 0) ++geo.j0;
        while (P0 - 64 + 32 * geo.j1 >= L) --geo.j1;
        geo.wave = wave; geo.tokb = tokb; geo.d = ts; geo.ibw = 4 * h - r - 32 * wave; geo.lt = lut + (g * 4 + hs) * 129;
        wg_stream(geo, kbase, vbase, ts, A, qf, tb, lane, tid);
        const float lt_ = A.l + __shfl_xor(A.l, 32), inv = 1.0f / lt_;
#if PART_HM
        o_store_t(A, inv, part + (size_t)(g * 4 + hs) * ((size_t)M * 128), qrow, 128, lds + RING_OFF + 65536 + wave * 8192, lane);
#else
        o_store_t(A, inv, part + g * 512 + hs * 128, qtok, D, lds + RING_OFF + 65536 + wave * 8192, lane);
#endif
        if (h == 0) lse[(size_t)qtok * 12 + g * 4 + hs] = A.m + __builtin_amdgcn_logf(lt_);
    }
}
struct GeoB { int j0, j1, wave, tokb, ibw; const LAS float* lt;
    __device__ __forceinline__ int tok0(int j) const { return tokb + 32 * j; }
    __device__ __forceinline__ bool active(int j) const { return j >= wave && j <= wave + 8; }
    __device__ __forceinline__ void logits(f32x16& st, int j) const { const int ib = 32 * j + ibw;
float bias[16]; lut16(bias, lt + ib);
        if (j - wave >= 1 && j - wave <= 7) {
#pragma unroll
            for (int i = 0; i < 16; ++i) st[i] = st[i] * (SM_SCALE * LOG2E) + bias[i];
        } else {
#pragma unroll
            for (int i = 0; i < 16; ++i) { const int idx = ib + crow16(i); st[i] = ((unsigned)idx <= 256u) ? st[i] * (SM_SCALE * LOG2E) + bias[i] : NEG_INF; }
        } }
};
__device__ __forceinline__ void attn_b_wg(const bf16* proj, bf16* mixed, const float* sink, LAS unsigned char* lds, int G, int wave, int lane, int tid) {
    LAS unsigned char* tb = lds + RING_OFF;
    const LAS float* lut = (const LAS float*)(lds + LUT_OFF) + 12 * 129;
    constexpr int U = 8 * (M / 256); const int vb = virt_block(G);
    const int r = lane & 31, h = lane >> 5;
    for (int k = 0; ; ++k) {
        const int u = k * G + vb; if (u >= U) break;
        const int hq = u & 3, blk = (u >> 2) % (M / 256), kvh = (u >> 2) / (M / 256), hd = kvh * 4 + hq;
        int T, sbase, b; seq_of_block256(blk, T, sbase, b);
        const int t0 = 256 * b, qtok = sbase + t0 + 32 * wave + r;
        bf16x8 qf[8]; q_load(qf, proj + (size_t)qtok * NPROJ + 4608 + hd * 128, lane);
        const bf16* kbase = proj + 4608 + 1024 + kvh * 128; const bf16* vbase = kbase + 256;
        AttnAcc A; acc_init(A, sink[hd] * LOG2E, h == 0 ? 1.f : 0.f);
        GeoB geo; geo.j0 = 0; geo.j1 = 15;
        while (t0 - 128 + 32 * geo.j0 < 0) ++geo.j0;
        while (t0 - 128 + 32 * geo.j1 >= T) --geo.j1;
        geo.wave = wave; geo.tokb = sbase + t0 - 128; geo.ibw = 4 * h - r - 32 * wave; geo.lt = lut + hd * 257;
        wg_stream(geo, kbase, vbase, 1, A, qf, tb, lane, tid);
        const float inv = 1.0f / (A.l + __shfl_xor(A.l, 32));
        o_store(A, inv, mixed + (size_t)qtok * 1536 + 512 + hd * 128, lane);
    }
}
struct GeoB2 { int j0, j1, qt, tokb, ibw; const LAS float* lt;
    __device__ __forceinline__ int tok0(int j) const { return tokb + 32 * j; }
    __device__ __forceinline__ bool active(int j) const { return j >= qt && j <= qt + 8; }
    __device__ __forceinline__ void logits(f32x16& st, int j) const { const int ib = 32 * j + ibw;
        float bias[16]; lut16(bias, lt + ib);
        if (j - qt >= 1 && j - qt <= 7) {
#pragma unroll
            for (int i = 0; i < 16; ++i) st[i] = st[i] * (SM_SCALE * LOG2E) + bias[i];
        } else {
#pragma unroll
            for (int i = 0; i < 16; ++i) { const int idx = ib + crow16(i); st[i] = ((unsigned)idx <= 256u) ? st[i] * (SM_SCALE * LOG2E) + bias[i] : NEG_INF; }
        } }
};
__device__ __forceinline__ void attn_b_gqa(const bf16* proj, bf16* mixed, const float* sink, LAS unsigned char* lds, int G, int wave, int lane, int tid) {
    LAS unsigned char* tb = lds + RING_OFF;
    const LAS float* lut = (const LAS float*)(lds + LUT_OFF) + 12 * 129;
    constexpr int U = 2 * (M / 64); const int vb = virt_block(G);
    const int r = lane & 31, h = lane >> 5, hq = wave & 3, qt = wave >> 2;
    for (int k = 0; ; ++k) {
        const int u = k * G + vb; if (u >= U) break;
        const int kvh = u / (M / 64), blk64 = u % (M / 64), hd = kvh * 4 + hq;
        int T, sbase, b; seq_of_block256(blk64 >> 2, T, sbase, b);
        const int t0 = 256 * b + 64 * (blk64 & 3), qtok = sbase + t0 + 32 * qt + r;
        bf16x8 qf[8]; q_load(qf, proj + PSLOT(36 + hd) + (size_t)qtok * PRS, lane);
        const bf16* kbase = proj + PSLOT(44 + kvh); const bf16* vbase = kbase + PSLOT(2);
        AttnAcc A; acc_init(A, sink[hd] * LOG2E, h == 0 ? 1.f : 0.f);
        GeoB2 geo; geo.j0 = 0; geo.j1 = 9;
        while (t0 - 128 + 32 * geo.j0 < 0) ++geo.j0;
        while (t0 - 128 + 32 * geo.j1 >= T) --geo.j1;
        geo.qt = qt; geo.tokb = sbase + t0 - 128; geo.ibw = 4 * h - r - 32 * qt; geo.lt = lut + hd * 257;
        wg_stream(geo, kbase, vbase, 1, A, qf, tb, lane, tid);
        const float inv = 1.0f / (A.l + __shfl_xor(A.l, 32));
        o_store_t(A, inv, mixed + 512 + hd * 128, qtok, 1536, lds + RING_OFF + 65536 + wave * 8192, lane);
    }
}
struct GeoC { int j0, j1, cb, tokb, glo, wlo, whi, rsq, csq, Rq, cq, h; const LAS float* lt;
    __device__ __forceinline__ int tok0(int j) const { return tokb + 32 * j; }
    __device__ __forceinline__ bool active(int j) const { const int krow = glo + (j >> 1); return krow >= wlo && krow <= whi && ((j & 1) == 0 ? cb <= 2 : cb >= 1); }
    __device__ __forceinline__ void logits(f32x16& st, int j) const {
        const int krow = glo + (j >> 1), ch = j & 1; const bool rowok = (unsigned)(krow - rsq) < 8u;
        const int cbq = 32 * ch + 4 * h - csq;
        const int ib = (krow - Rq + 7) * 31 + (32 * ch + 4 * h - cq + 15);
float bias[16]; lut16(bias, lt + ib);
#pragma unroll
        for (int i = 0; i < 16; ++i) st[i] = (rowok && (unsigned)(cbq + crow16(i)) < 16u) ? st[i] * (SM_SCALE * LOG2E) + bias[i] : NEG_INF; }
};
__device__ __forceinline__ void attn_c_wg(const bf16* proj, bf16* mixed, LAS unsigned char* lds, int G, int wave, int lane, int tid) {
    LAS unsigned char* tb = lds + RING_OFF;
    const LAS float* lut = (const LAS float*)(lds + LUT_OFF);
    constexpr int U = 16 * (M / 256); const int vb = virt_block(G);
    const int r = lane & 31, h = lane >> 5, rp = wave >> 2, cb = wave & 3;
    for (int k = 0; ; ++k) {
        const int u = k * G + vb; if (u >= U) break;
        const int hd = u / (M / 256), blk = u % (M / 256);
        int T, sbase, b; seq_of_block256(blk, T, sbase, b);
        const int rows = T >> 6, R0 = 4 * b;
        const int Rq = R0 + 2 * rp + (r >> 4), cq = 16 * cb + (r & 15), qtok = sbase + Rq * 64 + cq;
        int rsq = Rq - 4; rsq = rsq < 0 ? 0 : (rsq > rows - 8 ? rows - 8 : rsq);
        int csq = cq - 8; csq = csq < 0 ? 0 : (csq > 48 ? 48 : csq);
        int wlo = R0 + 2 * rp - 4; wlo = wlo < 0 ? 0 : (wlo > rows - 8 ? rows - 8 : wlo);
        int whi = R0 + 2 * rp - 3; whi = (whi < 0 ? 0 : (whi > rows - 8 ? rows - 8 : whi)) + 7;
        int glo = R0 - 4; glo = glo < 0 ? 0 : (glo > rows - 8 ? rows - 8 : glo);
        int ghi = R0 - 1; ghi = (ghi < 0 ? 0 : (ghi > rows - 8 ? rows - 8 : ghi)) + 7;
        bf16x8 qf[8]; q_load(qf, proj + (size_t)qtok * NPROJ + hd * 128, lane);
        const bf16* kbase = proj + 2048 + hd * 128; const bf16* vbase = kbase + 2048;
        AttnAcc A; acc_init(A, -1e30f, 0.f);
        GeoC geo; geo.j0 = 0; geo.j1 = 2 * (ghi - glo + 1) - 1; geo.cb = cb; geo.tokb = sbase + glo * 64; geo.glo = glo; geo.wlo = wlo; geo.whi = whi;
        geo.rsq = rsq; geo.csq = csq; geo.Rq = Rq; geo.cq = cq; geo.h = h; geo.lt = lut + hd * 465;
        wg_stream(geo, kbase, vbase, 1, A, qf, tb, lane, tid);
        const float inv = 1.0f / (A.l + __shfl_xor(A.l, 32));
        o_store(A, inv, mixed + (size_t)qtok * 2048 + hd * 128, lane);
    }
}

constexpr int ROWT_BYTES = 32768, ROWK_BYTES = 16384;
struct RowRegs { v4u k[2], v[2]; };
__device__ __forceinline__ void row_issue(RowRegs& R, const bf16* kbase, const bf16* vbase, int tok0, int tid) {
#pragma unroll
    for (int i = 0; i < 2; ++i) { const int n = tid + 512 * i; const size_t off = (size_t)(tok0 + (n >> 4)) * PRS + 8 * (n & 15);
        R.k[i] = *(const GAS v4u*)(kbase + off); R.v[i] = *(const GAS v4u*)(vbase + off); }
}
__device__ __forceinline__ void row_commit(LAS unsigned char* buf, const RowRegs& R, int tid) {
#pragma unroll
    for (int i = 0; i < 2; ++i) { const int n = tid + 512 * i; const unsigned o = off_a(n >> 4, n & 15);
        *(LAS v4u*)(buf + o) = R.k[i]; *(LAS v4u*)(buf + ROWK_BYTES + o) = R.v[i]; }
}
__device__ __forceinline__ void attn_c_rows(const bf16* proj, bf16* mixed, LAS unsigned char* lds, int G, int wave, int lane, int tid) {
    LAS unsigned char* tb = lds + RING_OFF;
    const LAS float* lut = (const LAS float*)(lds + LUT_OFF);
    constexpr int U = 16 * (M / 256); const int vb = virt_block(G);
    const int r = lane & 31, h = lane >> 5, rp = wave >> 2, cbk = wave & 3;
    int kc0 = 16 * cbk - 8; kc0 = kc0 < 0 ? 0 : (kc0 > 32 ? 32 : kc0);
    for (int k = 0; ; ++k) {
        const int u = k * G + vb; if (u >= U) break;
#if C_RECENT
        const int third = u / (16 * 64), rem = u % (16 * 64), hd = rem >> 6, jj = rem & 63, blk = 24 * (jj >> 3) + (2 - third) * 8 + (jj & 7);
#else
        const int hd = u / (M / 256), blk = u % (M / 256);
#endif
        int T, sbase, b; seq_of_block256(blk, T, sbase, b);
        const int rows = T >> 6, R0 = 4 * b;
        const int Rq = R0 + 2 * rp + (r >> 4), cq = 16 * cbk + (r & 15), qtok = sbase + Rq * 64 + cq;
        int rsq = Rq - 4; rsq = rsq < 0 ? 0 : (rsq > rows - 8 ? rows - 8 : rsq);
        int csq = cq - 8; csq = csq < 0 ? 0 : (csq > 48 ? 48 : csq);
        int wlo = R0 + 2 * rp - 4; wlo = wlo < 0 ? 0 : (wlo > rows - 8 ? rows - 8 : wlo);
        int whi = R0 + 2 * rp - 3; whi = (whi < 0 ? 0 : (whi > rows - 8 ? rows - 8 : whi)) + 7;
        int glo = R0 - 4; glo = glo < 0 ? 0 : (glo > rows - 8 ? rows - 8 : glo);
        int ghi = R0 - 1; ghi = (ghi < 0 ? 0 : (ghi > rows - 8 ? rows - 8 : ghi)) + 7;
        bf16x8 qf[8]; q_load(qf, proj + PSLOT(hd) + (size_t)qtok * PRS, lane);
        const bf16* kbase = proj + PSLOT(16 + hd); const bf16* vbase = kbase + PSLOT(16);
        const LAS float* lt = lut + hd * 465;
        AttnAcc A; acc_init(A, -1e30f, 0.f);
        const int j1 = ghi - glo, tokb = sbase + glo * 64;
#define ROW_BODY(jj) do { \
        { const int krow_ = glo + (jj); \
          if (krow_ >= wlo && krow_ <= whi) { const LAS unsigned char* kt_ = tb + ((jj) & 1) * ROWT_BYTES; \
            f32x16 st_ = qk_tile(kt_, qf, lane, kc0); \
            const bool rowok_ = (unsigned)(krow_ - rsq) < 8u; const int cb_ = kc0 + 4 * h - csq; const int ib_ = (krow_ - Rq + 7) * 31 + (kc0 + 4 * h - cq + 15); \
            float bias_[16]; lut16(bias_, lt + ib_); \
            _Pragma("unroll") for (int i = 0; i < 16; ++i) st_[i] = (rowok_ && (unsigned)(cb_ + crow16(i)) < 16u) ? st_[i] * (SM_SCALE * LOG2E) + bias_[i] : NEG_INF; \
            softmax_pv<true>(A, st_, kt_ + ROWK_BYTES, lane, kc0); } } } while (0)
#if ATT_ROWS_PD == 3
        RowRegs r0, r1, r2;
        row_issue(r0, kbase, vbase, tokb, tid);
        if (1 <= j1) row_issue(r1, kbase, vbase, tokb + 64, tid);
        if (2 <= j1) row_issue(r2, kbase, vbase, tokb + 128, tid);
        row_commit(tb, r0, tid);
        WG_BAR();
#define ROW_STEP(jj, RI, RC) do { \
        if ((jj) + 3 <= j1) row_issue(RI, kbase, vbase, tokb + 64 * ((jj) + 3), tid); \
        ROW_BODY(jj); \
        if ((jj) + 1 <= j1) row_commit(tb + (((jj) + 1) & 1) * ROWT_BYTES, RC, tid); \
        WG_BAR(); } while (0)
        for (int j = 0; j <= j1; j += 3) {
            ROW_STEP(j, r0, r1);
            if (j + 1 > j1) break;
            ROW_STEP(j + 1, r1, r2);
            if (j + 2 > j1) break;
            ROW_STEP(j + 2, r2, r0);
        }
#else
        RowRegs r0, r1;
        row_issue(r0, kbase, vbase, tokb, tid);
        if (1 <= j1) row_issue(r1, kbase, vbase, tokb + 64, tid);
        row_commit(tb, r0, tid);
        WG_BAR();
#define ROW_STEP(jj, RI, RC) do { \
        if ((jj) + 2 <= j1) row_issue(RI, kbase, vbase, tokb + 64 * ((jj) + 2), tid); \
        ROW_BODY(jj); \
        if ((jj) + 1 <= j1) row_commit(tb + (((jj) + 1) & 1) * ROWT_BYTES, RC, tid); \
        WG_BAR(); } while (0)
        for (int j = 0; j <= j1; j += 2) {
            ROW_STEP(j, r0, r1);
            if (j + 1 > j1) break;
            ROW_STEP(j + 1, r1, r0);
        }
#endif
#undef ROW_STEP
#undef ROW_BODY
        const float inv = 1.0f / (A.l + __shfl_xor(A.l, 32));
        o_store_t(A, inv, mixed + hd * 128, qtok, 2048, lds + RING_OFF + 65536 + wave * 8192, lane);
    }
}

constexpr int A2S_BUF = 32768;
struct A2Regs { v4u k[2], v[2]; };
__device__ __forceinline__ void a2_issue(A2Regs& R, const bf16* kbase, int tok0, int tstride, int tid) {
    const size_t off = (size_t)(tok0 + (tid >> 4) * tstride) * NPROJ + 8 * (tid & 15);
    R.k[0] = *(const GAS v4u*)(kbase + off); R.v[0] = *(const GAS v4u*)(kbase + 512 + off); R.k[1] = *(const GAS v4u*)(kbase + 128 + off); R.v[1] = *(const GAS v4u*)(kbase + 640 + off);
}
__device__ __forceinline__ void a2_commit(LAS unsigned char* buf, const A2Regs& R, int tid) {
    const unsigned o = off_a(tid >> 4, tid & 15);
    *(LAS v4u*)(buf + o) = R.k[0]; *(LAS v4u*)(buf + ATT_TILE_BYTES + o) = R.v[0]; *(LAS v4u*)(buf + WGT_BYTES + o) = R.k[1]; *(LAS v4u*)(buf + WGT_BYTES + ATT_TILE_BYTES + o) = R.v[1];
}
__device__ __forceinline__ void attn_a_2s(const bf16* proj, bf16* part, float* lse, LAS unsigned char* lds, int G, int wave, int lane, int tid) {
    LAS unsigned char* tb = lds + RING_OFF;
    const LAS float* lut = (const LAS float*)(lds + LUT_OFF);
    constexpr int U = 6 * (M / 128); const int vb = virt_block(G);
    const int r = lane & 31, h = lane >> 5, sw = wave & 1, qt = wave >> 1;
    for (int k = 0; ; ++k) {
        const int u = k * G + vb; if (u >= U) break;
        const int ghp = u / (M / 128), blk = u % (M / 128), g = ghp >> 1, hp = ghp & 1, hs = 2 * hp + sw, sh = 2 * g, d = 1 << sh;
        int T, sbase, b256; seq_of_block256(blk >> 1, T, sbase, b256);
        const int b = 2 * b256 + (blk & 1);
        const int l128 = (T >> 7) >> sh, rho = b / l128, P0 = 128 * (b % l128), L = 128 * l128;
        const int qtok = sbase + rho + d * (P0 + 32 * qt + r);
        bf16x8 qf[8]; q_load(qf, proj + (size_t)qtok * NPROJ + g * 1536 + hs * 128, lane);
        const bf16* kbase = proj + g * 1536 + 512 + 2 * hp * 128;
        const LAS float* lt = lut + (g * 4 + hs) * 129;
        AttnAcc A; acc_init(A, -1e30f, 0.f);
        int j0 = 0, j1 = 7;
        while (P0 - 64 + 32 * j0 < 0) ++j0;
        while (P0 - 64 + 32 * j1 >= L) --j1;
        const int tokb = sbase + rho + d * (P0 - 64), ibw = 4 * h - r - 32 * qt;
        A2Regs r0, r1;
        a2_issue(r0, kbase, tokb + d * 32 * j0, d, tid);
        if (j0 + 1 <= j1) a2_issue(r1, kbase, tokb + d * 32 * (j0 + 1), d, tid);
        a2_commit(tb + (j0 & 1) * A2S_BUF, r0, tid);
        WG_BAR();
#define A2_STEP(jj, RI, RC) do { \
        if ((jj) + 2 <= j1) a2_issue(RI, kbase, tokb + d * 32 * ((jj) + 2), d, tid); \
        if ((jj) >= qt && (jj) <= qt + 4) { const LAS unsigned char* kt_ = tb + ((jj) & 1) * A2S_BUF + sw * WGT_BYTES; \
            f32x16 st_ = qk_tile(kt_, qf, lane); \
            const int ib_ = 32 * (jj) + ibw;                                         \
            float bias_[16]; lut16(bias_, lt + ib_); \
            _Pragma("unroll") for (int i = 0; i < 16; ++i) { const int idx_ = ib_ + crow16(i); st_[i] = ((unsigned)idx_ <= 128u) ? st_[i] * (SM_SCALE * LOG2E) + bias_[i] : NEG_INF; } \
            softmax_pv<true>(A, st_, kt_ + ATT_TILE_BYTES, lane); } \
        if ((jj) + 1 <= j1) a2_commit(tb + (((jj) + 1) & 1) * A2S_BUF, RC, tid); \
        WG_BAR(); } while (0)
        for (int j = j0; j <= j1; j += 2) {
            A2_STEP(j, r0, r1);
            if (j + 1 > j1) break;
            A2_STEP(j + 1, r1, r0);
        }
#undef A2_STEP
        const float lt_ = A.l + __shfl_xor(A.l, 32), inv = 1.0f / lt_;
        o_store_t(A, inv, part + g * 512 + hs * 128, qtok, D, lds + RING_OFF + 65536 + wave * 8192, lane);
        if (h == 0) lse[(size_t)qtok * 12 + g * 4 + hs] = A.m + __builtin_amdgcn_logf(lt_);
    }
}

#define DMA_WAIT(n) asm volatile("s_waitcnt vmcnt(" #n ")" ::: "memory")
#define LDS_DONE() asm volatile("s_waitcnt lgkmcnt(0)" ::: "memory")
__device__ __forceinline__ void dma_voff(unsigned (&voff)[8], int tstride, int lane) {
#pragma unroll
    for (int i = 0; i < 8; ++i) { const int row = 8 * (i >> 1) + ((lane >> 2) & 7), x = (2 * (i >> 1) + ((lane >> 4) & 1)) & 3, ch = 4 * (2 * (i & 1) + (lane >> 5)) + ((lane & 3) ^ x);
        voff[i] = (unsigned)(row * tstride) * (unsigned)(PRS * 2) + 16u * ch; }
}
__device__ __forceinline__ void tile_dma(LAS unsigned char* tile, const bf16* base, int tok0, const unsigned (&voff)[8]) {
    const char* tb = (const char*)(base + (size_t)tok0 * PRS);
#pragma unroll
    for (int i = 0; i < 8; ++i) __builtin_amdgcn_global_load_lds((const unsigned*)(tb + voff[i]), (LAS unsigned*)(tile + 1024 * i), 16, 0, 0);
}
__device__ __forceinline__ void attn_a_dma(const bf16* proj, bf16* part, float* lse, LAS unsigned char* lds, int G, int wave, int lane) {
    LAS unsigned char* kt = lds + RING_OFF + wave * 16384; LAS unsigned char* vt = kt + ATT_TILE_BYTES;
    const LAS float* lut = (const LAS float*)(lds + LUT_OFF);
    constexpr int U = 12 * (M / 32); const int NGW = G * NWAVES, upw = (U + NGW - 1) / NGW, vw = virt_wave(G, wave);
    const int r = lane & 31, h = lane >> 5;
    for (int k = 0; k < upw; ++k) {
        const int u = k * NGW + vw; if (u >= U) break;
        const int gh = u / (M / 32), gb = u % (M / 32), g = gh >> 2, hs = gh & 3, sh = 2 * g;
        int T, sbase, b; seq_of_block(gb, T, sbase, b);
        const int l32 = (T >> 5) >> sh, rho = b / l32, p0 = 32 * (b % l32), L = 32 * l32, d = 1 << sh;
        const int qtok = sbase + rho + d * (p0 + r);
#if PROJ_HM
        const int tb0 = sbase + rho * L + p0 - 64, ts = 1;
        bf16x8 qf[8]; q_load(qf, proj + PSLOT(g * 12 + hs) + (size_t)(tb0 + 64 + r) * PRS, lane);
        const bf16* kbase = proj + PSLOT(g * 12 + 4 + hs); const bf16* vbase = kbase + PSLOT(4);
#else
        const int tb0 = sbase + rho + d * (p0 - 64), ts = d;
        bf16x8 qf[8]; q_load(qf, proj + (size_t)qtok * NPROJ + g * 1536 + hs * 128, lane);
        const bf16* kbase = proj + g * 1536 + 512 + hs * 128; const bf16* vbase = kbase + 512;
#endif
        const LAS float* lt = lut + (g * 4 + hs) * 129;
        AttnAcc A; acc_init(A, -1e30f, 0.f);
        int tt0 = 0, tt1 = 4;
        while (p0 - 64 + 32 * tt0 < 0) ++tt0;
        while (p0 - 64 + 32 * tt1 >= L) --tt1;
        unsigned voff[8]; dma_voff(voff, ts, lane);
        LDS_DONE();
        tile_dma(kt, kbase, tb0 + ts * 32 * tt0, voff); tile_dma(vt, vbase, tb0 + ts * 32 * tt0, voff);
        for (int tt = tt0; tt <= tt1; ++tt) {
            const bool more = tt < tt1; const int nk = tb0 + ts * 32 * (tt + 1);
            DMA_WAIT(8);
            f32x16 st = qk_tile(kt, qf, lane);
            const int ib = 32 * tt + 4 * h - r;
            float bias[16]; lut16(bias, lt + ib);
            LDS_DONE();
            if (more) tile_dma(kt, kbase, nk, voff);
            if (tt >= 1 && tt <= 3) {
#pragma unroll
                for (int i = 0; i < 16; ++i) st[i] = st[i] * (SM_SCALE * LOG2E) + bias[i];
            } else {
#pragma unroll
                for (int i = 0; i < 16; ++i) { const int idx = ib + crow16(i); st[i] = ((unsigned)idx <= 128u) ? st[i] * (SM_SCALE * LOG2E) + bias[i] : NEG_INF; }
            }
            if (more) DMA_WAIT(8); else DMA_WAIT(0);
            softmax_pv<true>(A, st, vt, lane);
            LDS_DONE();
            if (more) tile_dma(vt, vbase, nk, voff);
        }
        const float lt_ = A.l + __shfl_xor(A.l, 32), inv = 1.0f / lt_;
#if PART_HM
        o_store_t(A, inv, part + (size_t)(g * 4 + hs) * ((size_t)M * 128), tb0 + 64 + r, 128, kt, lane);
#else
        o_store_t(A, inv, part + g * 512 + hs * 128, qtok, D, kt, lane);
#endif
        if (h == 0) lse[(size_t)qtok * 12 + g * 4 + hs] = A.m + __builtin_amdgcn_logf(lt_);
    }
}
#if PROJ_HM && PART_HM
struct AUnit { int g, hs, tb0, qtok0, d, tt0, tt1; };
__device__ __forceinline__ void a_decode(int u, AUnit& a) {
    const int gh = u / (M / 32), gb = u % (M / 32); a.g = gh >> 2; a.hs = gh & 3; const int sh = 2 * a.g;
    int T, sbase, b; seq_of_block(gb, T, sbase, b);
    const int l32 = (T >> 5) >> sh, rho = b / l32, p0 = 32 * (b % l32), L = 32 * l32; a.d = 1 << sh;
    a.tb0 = sbase + rho * L + p0 - 64; a.qtok0 = sbase + rho + a.d * p0;
    a.tt0 = 0; a.tt1 = 4;
    while (p0 - 64 + 32 * a.tt0 < 0) ++a.tt0;
    while (p0 - 64 + 32 * a.tt1 >= L) --a.tt1;
}
__device__ __forceinline__ void attn_a_xpf(const bf16* proj, bf16* part, float* lse, LAS unsigned char* lds, int G, int wave, int lane) {
    LAS unsigned char* kt = lds + RING_OFF + wave * 16384; LAS unsigned char* vt = kt + ATT_TILE_BYTES;
    const LAS float* lut = (const LAS float*)(lds + LUT_OFF);
    constexpr int U = 12 * (M / 32); const int NGW = G * NWAVES, vw = virt_wave(G, wave);
    const int r = lane & 31, h = lane >> 5;
    if (vw >= U) return;
    unsigned voff[8]; dma_voff(voff, 1, lane);
    AUnit cu; a_decode(vw, cu);
    bf16x8 qf[8]; q_load(qf, proj + PSLOT(cu.g * 12 + cu.hs) + (size_t)(cu.tb0 + 64 + r) * PRS, lane);
    LDS_DONE();
    tile_dma(kt, proj + PSLOT(cu.g * 12 + 4 + cu.hs), cu.tb0 + 32 * cu.tt0, voff); tile_dma(vt, proj + PSLOT(cu.g * 12 + 8 + cu.hs), cu.tb0 + 32 * cu.tt0, voff);
    for (int u = vw; u < U; u += NGW) {
        const bool has_next = u + NGW < U; AUnit nx = cu; if (has_next) a_decode(u + NGW, nx);
        const bf16* kbase = proj + PSLOT(cu.g * 12 + 4 + cu.hs); const bf16* vbase = kbase + PSLOT(4);
        const LAS float* lt = lut + (cu.g * 4 + cu.hs) * 129;
        AttnAcc A; acc_init(A, -1e30f, 0.f);
        for (int tt = cu.tt0; tt <= cu.tt1; ++tt) {
            const bool more = tt < cu.tt1; const int nk = cu.tb0 + 32 * (tt + 1);
            DMA_WAIT(8);
            f32x16 st = qk_tile(kt, qf, lane);
            const int ib = 32 * tt + 4 * h - r;
            float bias[16]; lut16(bias, lt + ib);
            LDS_DONE();
            if (more) tile_dma(kt, kbase, nk, voff);
            else if (has_next) tile_dma(kt, proj + PSLOT(nx.g * 12 + 4 + nx.hs), nx.tb0 + 32 * nx.tt0, voff);
            if (tt >= 1 && tt <= 3) {
#pragma unroll
                for (int i = 0; i < 16; ++i) st[i] = st[i] * (SM_SCALE * LOG2E) + bias[i];
            } else {
#pragma unroll
                for (int i = 0; i < 16; ++i) { const int idx = ib + crow16(i); st[i] = ((unsigned)idx <= 128u) ? st[i] * (SM_SCALE * LOG2E) + bias[i] : NEG_INF; }
            }
            if (more || has_next) DMA_WAIT(8); else DMA_WAIT(0);
            softmax_pv<true>(A, st, vt, lane);
            LDS_DONE();
            if (more) tile_dma(vt, vbase, nk, voff);
        }
        if (has_next) q_load(qf, proj + PSLOT(nx.g * 12 + nx.hs) + (size_t)(nx.tb0 + 64 + r) * PRS, lane);
        const float lt_ = A.l + __shfl_xor(A.l, 32), inv = 1.0f / lt_;
        o_store_t(A, inv, part + (size_t)(cu.g * 4 + cu.hs) * ((size_t)M * 128), cu.tb0 + 64 + r, 128, vt, lane);
        if (h == 0) lse[(size_t)(cu.qtok0 + cu.d * r) * 12 + cu.g * 4 + cu.hs] = A.m + __builtin_amdgcn_logf(lt_);
        if (has_next) tile_dma(vt, proj + PSLOT(nx.g * 12 + 8 + nx.hs), nx.tb0 + 32 * nx.tt0, voff);
        cu = nx;
    }
}
#endif
__device__ __forceinline__ void attn_c_dma(const bf16* proj, bf16* mixed, LAS unsigned char* lds, int G, int wave, int lane) {
    LAS unsigned char* kt = lds + RING_OFF + wave * 16384; LAS unsigned char* vt = kt + ATT_TILE_BYTES;
    const LAS float* lut = (const LAS float*)(lds + LUT_OFF);
    constexpr int U = 16 * (M / 32); const int NGW = G * NWAVES, upw = (U + NGW - 1) / NGW, vw = virt_wave(G, wave);
    const int r = lane & 31, h = lane >> 5; unsigned voff[8]; dma_voff(voff, 1, lane);
    for (int k = 0; k < upw; ++k) {
        const int u = k * NGW + vw; if (u >= U) break;
        const int hd = u / (M / 32), gbc = u % (M / 32), rp = gbc >> 2, c0 = 16 * (gbc & 3);
        int rows, sbase, R0;
        if (rp < 128) { rows = 64; sbase = (rp >> 5) * 4096; R0 = 2 * (rp & 31); } else { const int r2 = rp - 128; rows = 128; sbase = M_PROMPT + (r2 >> 6) * 8192; R0 = 2 * (r2 & 63); }
        const int Rq = R0 + (r >> 4), cq = c0 + (r & 15), qtok = sbase + Rq * 64 + cq;
        int rsq = Rq - 4; rsq = rsq < 0 ? 0 : (rsq > rows - 8 ? rows - 8 : rsq);
        int csq = cq - 8; csq = csq < 0 ? 0 : (csq > 48 ? 48 : csq);
        int rlo = R0 - 4; rlo = rlo < 0 ? 0 : (rlo > rows - 8 ? rows - 8 : rlo);
        int rhi = R0 - 3; rhi = (rhi < 0 ? 0 : (rhi > rows - 8 ? rows - 8 : rhi)) + 7;
        int kc0 = c0 - 8; kc0 = kc0 < 0 ? 0 : (kc0 > 32 ? 32 : kc0);
        bf16x8 qf[8]; q_load(qf, proj + (size_t)qtok * NPROJ + hd * 128, lane);
        const bf16* kbase = proj + 2048 + hd * 128; const bf16* vbase = kbase + 2048;
        const LAS float* lt = lut + hd * 465;
        AttnAcc A; acc_init(A, -1e30f, 0.f);
        LDS_DONE();
        tile_dma(kt, kbase, sbase + rlo * 64 + kc0, voff); tile_dma(vt, vbase, sbase + rlo * 64 + kc0, voff);
        for (int krow = rlo; krow <= rhi; ++krow) {
            const bool more = krow < rhi; const int nk = sbase + (krow + 1) * 64 + kc0;
            DMA_WAIT(8);
            f32x16 st = qk_tile(kt, qf, lane);
            const bool rowok = (unsigned)(krow - rsq) < 8u;
            const int cb = kc0 + 4 * h - csq;
            const int ib = (krow - Rq + 7) * 31 + (kc0 + 4 * h - cq + 15);
            float bias[16]; lut16(bias, lt + ib);
            LDS_DONE();
            if (more) tile_dma(kt, kbase, nk, voff);
#pragma unroll
            for (int i = 0; i < 16; ++i) st[i] = (rowok && (unsigned)(cb + crow16(i)) < 16u) ? st[i] * (SM_SCALE * LOG2E) + bias[i] : NEG_INF;
            if (more) DMA_WAIT(8); else DMA_WAIT(0);
            softmax_pv<true>(A, st, vt, lane);
            LDS_DONE();
            if (more) tile_dma(vt, vbase, nk, voff);
        }
        const float inv = 1.0f / (A.l + __shfl_xor(A.l, 32));
        o_store(A, inv, mixed + (size_t)qtok * 2048 + hd * 128, lane);
    }
}

#if ATT_A_WG == 2
#define ATTN_A(proj, part, lse, lds, G, wave, lane, tid) attn_a_2s(proj, part, lse, lds, G, wave, lane, tid)
#elif ATT_A_WG
#define ATTN_A(proj, part, lse, lds, G, wave, lane, tid) attn_a_wg(proj, part, lse, lds, G, wave, lane, tid)
#else
#if ATT_DMA && ATT_A_XPF && PROJ_HM && PART_HM
#define ATTN_A(proj, part, lse, lds, G, wave, lane, tid) attn_a_xpf(proj, part, lse, lds, G, wave, lane)
#elif ATT_DMA
#define ATTN_A(proj, part, lse, lds, G, wave, lane, tid) attn_a_dma(proj, part, lse, lds, G, wave, lane)
#else
#define ATTN_A(proj, part, lse, lds, G, wave, lane, tid) attn_a_mfma(proj, part, lse, lds, G, wave, lane)
#endif
#endif
#if ATT_B_WG
#define ATTN_B(proj, mixed, sink, lds, G, wave, lane, tid) attn_b_gqa(proj, mixed, sink, lds, G, wave, lane, tid)
#else
#define ATTN_B(proj, mixed, sink, lds, G, wave, lane, tid) attn_b_mfma(proj, mixed, sink, lds, G, wave, lane)
#endif
#if ATT_C_WG
#define ATTN_C(proj, mixed, lds, G, wave, lane, tid) attn_c_rows(proj, mixed, lds, G, wave, lane, tid)
#else
#if ATT_DMA
#define ATTN_C(proj, mixed, lds, G, wave, lane, tid) attn_c_dma(proj, mixed, lds, G, wave, lane)
#else
#define ATTN_C(proj, mixed, lds, G, wave, lane, tid) attn_c_mfma(proj, mixed, lds, G, wave, lane)
#endif
#endif

struct Args { const float* in[15]; float* out; unsigned char* ws; int ph_lo, ph_hi; };
static_assert(sizeof(Args) == 17 * 8 + 8, "Args has no holes");
template <bool FUSE_T>
__global__ void __launch_bounds__(NWAVES * 64, 2) enc_fwd(Args args) {
    extern __shared__ __attribute__((aligned(16))) unsigned char lds_raw[];
    LAS unsigned char* lds = (LAS unsigned char*)lds_raw;
    volatile LAS unsigned* MISC = (volatile LAS unsigned*)(lds + MISC_OFF);
    const int tid = threadIdx.x, lane = tid & 63, wave = __builtin_amdgcn_readfirstlane(tid >> 6);
    const int G = gridDim.x, gw = blockIdx.x * NWAVES + wave, NGW = G * NWAVES;
    unsigned char* ws = args.ws;
    gu32* ctl = (gu32*)(ws + WS_CTL);
    bf16* PART = (bf16*)args.out;
    bf16* XB = (bf16*)(ws + WS_XB); bf16* MIX = (bf16*)(ws + WS_MIX); bf16* PROJ = (bf16*)(ws + WS_PROJ);
    pg8::u64* SSQ = (pg8::u64*)(ws + WS_SSQ);
    for (int u = tid; u < (LDS_BYTES - LDSCTL_OFF) / 4; u += NWAVES * 64) ((LAS unsigned*)(lds + LDSCTL_OFF))[u] = 0u;
    __syncthreads();
    XcdBarrier bar; bar.bar = (unsigned*)(ctl + CW_BAR); bar.x = 0; bar.st = nullptr;
    if (!PER_PHASE_LAUNCH) bar = xcd_barrier_post((unsigned*)(ctl + CW_BAR), MISC + 8);
    const int lo = args.ph_lo, hi = args.ph_hi;
#define IN(k) (lo <= (k) && (k) < hi)
#define SEAM(k) do { if (!PER_PHASE_LAUNCH && IN(k) && IN((k) + 1)) xcd_barrier(bar); } while (0)
    LAS float* scr = (LAS float*)(lds + RING_OFF + wave * 16384);

    if (IN(0)) {
        prologue_rows(args.in[0], args.in[1], XB, SSQ, gw, NGW, lane);
        cvt_set(args.in, ws, 3, 0, 0, scr, gw, NGW, lane);
    }
    SEAM(0);
    { constexpr int L = 0;
        const int pb = 1 + 6 * L;
        const int ko = (L & 1) ? 2048 : 1536;
        if (IN(pb)) {
            pg8::Gemm g{XB, (const bf16*)(ws + WS_WIN), M, NPROJ, D}; pg8::StaticOrder S; S.init(M, NPROJ, G, (int)blockIdx.x, WGM_WIDE);
            pg8::EpiProj E{PROJ, NPROJ, SSQ + (size_t)(2 * L) * M, (L & 1) ? 0 : 3};
            if constexpr (NAP_L0 > 0 && L == 0) pg8::gemm_phase<pg8::EpiProj, pg8::StaticOrder, GEMM_ALIGN_EPI, GEMM_SP2, NAP_L0>(lds + RING_OFF, g, S, E);
            else
            pg8::gemm_phase<pg8::EpiProj, pg8::StaticOrder, GEMM_ALIGN_EPI, GEMM_SP2>(lds + RING_OFF, g, S, E);
        }
        SEAM(pb);
        if (IN(pb + 1)) {
            if (L & 1) lut_fill_c(args.in[7] + (size_t)(L >> 1) * 16 * 15 * 31, lds, tid); else lut_fill_ab(args.in[8], lds, tid);
#if !ATT_FIRST
            cvt_set(args.in, ws, (L + 1 < DEPTH ? 1 : 0) | (L >= 1 ? 2 : 0), L + 1 < DEPTH ? L + 1 : L, L, scr, gw, NGW, lane);
#endif
            __syncthreads();
            if (ATT_STATIC_PRIO && wave >= 4) __builtin_amdgcn_s_setprio(1);
            if (L & 1) ATTN_C(PROJ, MIX, lds, G, wave, lane, tid);
            else ATTN_A(PROJ, PART, (float*)(ws + WS_LSE), lds, G, wave, lane, tid);
            if (ATT_STATIC_PRIO) __builtin_amdgcn_s_setprio(0);
#if ATT_FIRST
            __syncthreads();
            cvt_set(args.in, ws, (L + 1 < DEPTH ? 1 : 0) | (L >= 1 ? 2 : 0), L + 1 < DEPTH ? L + 1 : L, L, scr, gw, NGW, lane);
#endif
        }
        SEAM(pb + 1);
        if (!(L & 1)) {
            if (IN(pb + 2)) {
                lut_fill_ab(args.in[8], lds, tid); __syncthreads();
                if (ATT_STATIC_PRIO && wave >= 4) __builtin_amdgcn_s_setprio(1);
                merge_a(PART, (const float*)(ws + WS_LSE), MIX, gw, NGW, lane);
                ATTN_B(PROJ, MIX, args.in[4] + (size_t)(L >> 1) * 8, lds, G, wave, lane, tid);
                if (ATT_STATIC_PRIO) __builtin_amdgcn_s_setprio(0);
            }
            SEAM(pb + 2);
        }
        if (IN(pb + 3)) {
            pg8::Gemm g{MIX, (const bf16*)(ws + WS_WOUT), M, D, ko}; pg8::StaticOrder S; S.init(M, D, G, (int)blockIdx.x, WGM_RES);
            pg8::EpiResid E{XB, SSQ + (size_t)(2 * L + 1) * M, D, 1.0f};
            pg8::gemm_phase<pg8::EpiResid, pg8::StaticOrder, GEMM_ALIGN_EPI, GEMM_SP2>(lds + RING_OFF, g, S, E);
        }
        SEAM(pb + 3);
        if (IN(pb + 4)) {
            pg8::Gemm g{XB, (const bf16*)(ws + WS_WGU), M, NGU, D}; pg8::StaticOrder S; S.init(M, NGU, G, (int)blockIdx.x, WGM_WIDE);
            pg8::EpiGateUp E{PROJ, FF, SSQ + (size_t)(2 * L + 1) * M};
            pg8::gemm_phase<pg8::EpiGateUp, pg8::StaticOrder, GEMM_ALIGN_EPI, GEMM_SP2>(lds + RING_OFF, g, S, E);
        }
        SEAM(pb + 4);
        if (IN(pb + 5)) {
            pg8::Gemm g{PROJ, (const bf16*)(ws + WS_WDN), M, D, FF}; pg8::StaticOrder S; S.init(M, D, G, (int)blockIdx.x, WGM_RES); S.rev = DOWN_REV;
            if constexpr (FUSE_T && L == DEPTH - 1) {
                pg8::EpiFinal E{XB, SSQ + (size_t)(2 * L + 2) * M, (unsigned*)(ctl + CW_FIN), args.in[14], args.out, D};
                pg8::gemm_phase<pg8::EpiFinal, pg8::StaticOrder, GEMM_ALIGN_EPI, GEMM_SP2>(lds + RING_OFF, g, S, E);
            } else {
            pg8::EpiResid E{XB, SSQ + (size_t)(2 * L + 2) * M, D, 1.0f};
            pg8::gemm_phase<pg8::EpiResid, pg8::StaticOrder, GEMM_ALIGN_EPI, GEMM_SP2>(lds + RING_OFF, g, S, E);
            }
        }
        if (!(FUSE_T && L == DEPTH - 1)) SEAM(pb + 5);
    }
    { constexpr int L = 1;
        const int pb = 1 + 6 * L;
        const int ko = (L & 1) ? 2048 : 1536;
        if (IN(pb)) {
            pg8::Gemm g{XB, (const bf16*)(ws + WS_WIN), M, NPROJ, D}; pg8::StaticOrder S; S.init(M, NPROJ, G, (int)blockIdx.x, WGM_WIDE);
            pg8::EpiProj E{PROJ, NPROJ, SSQ + (size_t)(2 * L) * M, (L & 1) ? 0 : 3};
            if constexpr (NAP_L0 > 0 && L == 0) pg8::gemm_phase<pg8::EpiProj, pg8::StaticOrder, GEMM_ALIGN_EPI, GEMM_SP2, NAP_L0>(lds + RING_OFF, g, S, E);
            else
            pg8::gemm_phase<pg8::EpiProj, pg8::StaticOrder, GEMM_ALIGN_EPI, GEMM_SP2>(lds + RING_OFF, g, S, E);
        }
        SEAM(pb);
        if (IN(pb + 1)) {
            if (L & 1) lut_fill_c(args.in[7] + (size_t)(L >> 1) * 16 * 15 * 31, lds, tid); else lut_fill_ab(args.in[8], lds, tid);
#if !ATT_FIRST
            cvt_set(args.in, ws, (L + 1 < DEPTH ? 1 : 0) | (L >= 1 ? 2 : 0), L + 1 < DEPTH ? L + 1 : L, L, scr, gw, NGW, lane);
#endif
            __syncthreads();
            if (ATT_STATIC_PRIO && wave >= 4) __builtin_amdgcn_s_setprio(1);
            if (L & 1) ATTN_C(PROJ, MIX, lds, G, wave, lane, tid);
            else ATTN_A(PROJ, PART, (float*)(ws + WS_LSE), lds, G, wave, lane, tid);
            if (ATT_STATIC_PRIO) __builtin_amdgcn_s_setprio(0);
#if ATT_FIRST
            __syncthreads();
            cvt_set(args.in, ws, (L + 1 < DEPTH ? 1 : 0) | (L >= 1 ? 2 : 0), L + 1 < DEPTH ? L + 1 : L, L, scr, gw, NGW, lane);
#endif
        }
        SEAM(pb + 1);
        if (!(L & 1)) {
            if (IN(pb + 2)) {
                lut_fill_ab(args.in[8], lds, tid); __syncthreads();
                if (ATT_STATIC_PRIO && wave >= 4) __builtin_amdgcn_s_setprio(1);
                merge_a(PART, (const float*)(ws + WS_LSE), MIX, gw, NGW, lane);
                ATTN_B(PROJ, MIX, args.in[4] + (size_t)(L >> 1) * 8, lds, G, wave, lane, tid);
                if (ATT_STATIC_PRIO) __builtin_amdgcn_s_setprio(0);
            }
            SEAM(pb + 2);
        }
        if (IN(pb + 3)) {
            pg8::Gemm g{MIX, (const bf16*)(ws + WS_WOUT), M, D, ko}; pg8::StaticOrder S; S.init(M, D, G, (int)blockIdx.x, WGM_RES);
            pg8::EpiResid E{XB, SSQ + (size_t)(2 * L + 1) * M, D, 1.0f};
            pg8::gemm_phase<pg8::EpiResid, pg8::StaticOrder, GEMM_ALIGN_EPI, GEMM_SP2>(lds + RING_OFF, g, S, E);
        }
        SEAM(pb + 3);
        if (IN(pb + 4)) {
            pg8::Gemm g{XB, (const bf16*)(ws + WS_WGU), M, NGU, D}; pg8::StaticOrder S; S.init(M, NGU, G, (int)blockIdx.x, WGM_WIDE);
            pg8::EpiGateUp E{PROJ, FF, SSQ + (size_t)(2 * L + 1) * M};
            pg8::gemm_phase<pg8::EpiGateUp, pg8::StaticOrder, GEMM_ALIGN_EPI, GEMM_SP2>(lds + RING_OFF, g, S, E);
        }
        SEAM(pb + 4);
        if (IN(pb + 5)) {
            pg8::Gemm g{PROJ, (const bf16*)(ws + WS_WDN), M, D, FF}; pg8::StaticOrder S; S.init(M, D, G, (int)blockIdx.x, WGM_RES); S.rev = DOWN_REV;
            if constexpr (FUSE_T && L == DEPTH - 1) {
                pg8::EpiFinal E{XB, SSQ + (size_t)(2 * L + 2) * M, (unsigned*)(ctl + CW_FIN), args.in[14], args.out, D};
                pg8::gemm_phase<pg8::EpiFinal, pg8::StaticOrder, GEMM_ALIGN_EPI, GEMM_SP2>(lds + RING_OFF, g, S, E);
            } else {
            pg8::EpiResid E{XB, SSQ + (size_t)(2 * L + 2) * M, D, 1.0f};
            pg8::gemm_phase<pg8::EpiResid, pg8::StaticOrder, GEMM_ALIGN_EPI, GEMM_SP2>(lds + RING_OFF, g, S, E);
            }
        }
        if (!(FUSE_T && L == DEPTH - 1)) SEAM(pb + 5);
    }
    { constexpr int L = 2;
        const int pb = 1 + 6 * L;
        const int ko = (L & 1) ? 2048 : 1536;
        if (IN(pb)) {
            pg8::Gemm g{XB, (const bf16*)(ws + WS_WIN), M, NPROJ, D}; pg8::StaticOrder S; S.init(M, NPROJ, G, (int)blockIdx.x, WGM_WIDE);
            pg8::EpiProj E{PROJ, NPROJ, SSQ + (size_t)(2 * L) * M, (L & 1) ? 0 : 3};
            if constexpr (NAP_L0 > 0 && L == 0) pg8::gemm_phase<pg8::EpiProj, pg8::StaticOrder, GEMM_ALIGN_EPI, GEMM_SP2, NAP_L0>(lds + RING_OFF, g, S, E);
            else
            pg8::gemm_phase<pg8::EpiProj, pg8::StaticOrder, GEMM_ALIGN_EPI, GEMM_SP2>(lds + RING_OFF, g, S, E);
        }
        SEAM(pb);
        if (IN(pb + 1)) {
            if (L & 1) lut_fill_c(args.in[7] + (size_t)(L >> 1) * 16 * 15 * 31, lds, tid); else lut_fill_ab(args.in[8], lds, tid);
#if !ATT_FIRST
            cvt_set(args.in, ws, (L + 1 < DEPTH ? 1 : 0) | (L >= 1 ? 2 : 0), L + 1 < DEPTH ? L + 1 : L, L, scr, gw, NGW, lane);
#endif
            __syncthreads();
            if (ATT_STATIC_PRIO && wave >= 4) __builtin_amdgcn_s_setprio(1);
            if (L & 1) ATTN_C(PROJ, MIX, lds, G, wave, lane, tid);
            else ATTN_A(PROJ, PART, (float*)(ws + WS_LSE), lds, G, wave, lane, tid);
            if (ATT_STATIC_PRIO) __builtin_amdgcn_s_setprio(0);
#if ATT_FIRST
            __syncthreads();
            cvt_set(args.in, ws, (L + 1 < DEPTH ? 1 : 0) | (L >= 1 ? 2 : 0), L + 1 < DEPTH ? L + 1 : L, L, scr, gw, NGW, lane);
#endif
        }
        SEAM(pb + 1);
        if (!(L & 1)) {
            if (IN(pb + 2)) {
                lut_fill_ab(args.in[8], lds, tid); __syncthreads();
                if (ATT_STATIC_PRIO && wave >= 4) __builtin_amdgcn_s_setprio(1);
                merge_a(PART, (const float*)(ws + WS_LSE), MIX, gw, NGW, lane);
                ATTN_B(PROJ, MIX, args.in[4] + (size_t)(L >> 1) * 8, lds, G, wave, lane, tid);
                if (ATT_STATIC_PRIO) __builtin_amdgcn_s_setprio(0);
            }
            SEAM(pb + 2);
        }
        if (IN(pb + 3)) {
            pg8::Gemm g{MIX, (const bf16*)(ws + WS_WOUT), M, D, ko}; pg8::StaticOrder S; S.init(M, D, G, (int)blockIdx.x, WGM_RES);
            pg8::EpiResid E{XB, SSQ + (size_t)(2 * L + 1) * M, D, 1.0f};
            pg8::gemm_phase<pg8::EpiResid, pg8::StaticOrder, GEMM_ALIGN_EPI, GEMM_SP2>(lds + RING_OFF, g, S, E);
        }
        SEAM(pb + 3);
        if (IN(pb + 4)) {
            pg8::Gemm g{XB, (const bf16*)(ws + WS_WGU), M, NGU, D}; pg8::StaticOrder S; S.init(M, NGU, G, (int)blockIdx.x, WGM_WIDE);
            pg8::EpiGateUp E{PROJ, FF, SSQ + (size_t)(2 * L + 1) * M};
            pg8::gemm_phase<pg8::EpiGateUp, pg8::StaticOrder, GEMM_ALIGN_EPI, GEMM_SP2>(lds + RING_OFF, g, S, E);
        }
        SEAM(pb + 4);
        if (IN(pb + 5)) {
            pg8::Gemm g{PROJ, (const bf16*)(ws + WS_WDN), M, D, FF}; pg8::StaticOrder S; S.init(M, D, G, (int)blockIdx.x, WGM_RES); S.rev = DOWN_REV;
            if constexpr (FUSE_T && L == DEPTH - 1) {
                pg8::EpiFinal E{XB, SSQ + (size_t)(2 * L + 2) * M, (unsigned*)(ctl + CW_FIN), args.in[14], args.out, D};
                pg8::gemm_phase<pg8::EpiFinal, pg8::StaticOrder, GEMM_ALIGN_EPI, GEMM_SP2>(lds + RING_OFF, g, S, E);
            } else {
            pg8::EpiResid E{XB, SSQ + (size_t)(2 * L + 2) * M, D, 1.0f};
            pg8::gemm_phase<pg8::EpiResid, pg8::StaticOrder, GEMM_ALIGN_EPI, GEMM_SP2>(lds + RING_OFF, g, S, E);
            }
        }
        if (!(FUSE_T && L == DEPTH - 1)) SEAM(pb + 5);
    }
    { constexpr int L = 3;
        const int pb = 1 + 6 * L;
        const int ko = (L & 1) ? 2048 : 1536;
        if (IN(pb)) {
            pg8::Gemm g{XB, (const bf16*)(ws + WS_WIN), M, NPROJ, D}; pg8::StaticOrder S; S.init(M, NPROJ, G, (int)blockIdx.x, WGM_WIDE);
            pg8::EpiProj E{PROJ, NPROJ, SSQ + (size_t)(2 * L) * M, (L & 1) ? 0 : 3};
            if constexpr (NAP_L0 > 0 && L == 0) pg8::gemm_phase<pg8::EpiProj, pg8::StaticOrder, GEMM_ALIGN_EPI, GEMM_SP2, NAP_L0>(lds + RING_OFF, g, S, E);
            else
            pg8::gemm_phase<pg8::EpiProj, pg8::StaticOrder, GEMM_ALIGN_EPI, GEMM_SP2>(lds + RING_OFF, g, S, E);
        }
        SEAM(pb);
        if (IN(pb + 1)) {
            if (L & 1) lut_fill_c(args.in[7] + (size_t)(L >> 1) * 16 * 15 * 31, lds, tid); else lut_fill_ab(args.in[8], lds, tid);
#if !ATT_FIRST
            cvt_set(args.in, ws, (L + 1 < DEPTH ? 1 : 0) | (L >= 1 ? 2 : 0), L + 1 < DEPTH ? L + 1 : L, L, scr, gw, NGW, lane);
#endif
            __syncthreads();
            if (ATT_STATIC_PRIO && wave >= 4) __builtin_amdgcn_s_setprio(1);
            if (L & 1) ATTN_C(PROJ, MIX, lds, G, wave, lane, tid);
            else ATTN_A(PROJ, PART, (float*)(ws + WS_LSE), lds, G, wave, lane, tid);
            if (ATT_STATIC_PRIO) __builtin_amdgcn_s_setprio(0);
#if ATT_FIRST
            __syncthreads();
            cvt_set(args.in, ws, (L + 1 < DEPTH ? 1 : 0) | (L >= 1 ? 2 : 0), L + 1 < DEPTH ? L + 1 : L, L, scr, gw, NGW, lane);
#endif
        }
        SEAM(pb + 1);
        if (!(L & 1)) {
            if (IN(pb + 2)) {
                lut_fill_ab(args.in[8], lds, tid); __syncthreads();
                if (ATT_STATIC_PRIO && wave >= 4) __builtin_amdgcn_s_setprio(1);
                merge_a(PART, (const float*)(ws + WS_LSE), MIX, gw, NGW, lane);
                ATTN_B(PROJ, MIX, args.in[4] + (size_t)(L >> 1) * 8, lds, G, wave, lane, tid);
                if (ATT_STATIC_PRIO) __builtin_amdgcn_s_setprio(0);
            }
            SEAM(pb + 2);
        }
        if (IN(pb + 3)) {
            pg8::Gemm g{MIX, (const bf16*)(ws + WS_WOUT), M, D, ko}; pg8::StaticOrder S; S.init(M, D, G, (int)blockIdx.x, WGM_RES);
            pg8::EpiResid E{XB, SSQ + (size_t)(2 * L + 1) * M, D, 1.0f};
            pg8::gemm_phase<pg8::EpiResid, pg8::StaticOrder, GEMM_ALIGN_EPI, GEMM_SP2>(lds + RING_OFF, g, S, E);
        }
        SEAM(pb + 3);
        if (IN(pb + 4)) {
            pg8::Gemm g{XB, (const bf16*)(ws + WS_WGU), M, NGU, D}; pg8::StaticOrder S; S.init(M, NGU, G, (int)blockIdx.x, WGM_WIDE);
            pg8::EpiGateUp E{PROJ, FF, SSQ + (size_t)(2 * L + 1) * M};
            pg8::gemm_phase<pg8::EpiGateUp, pg8::StaticOrder, GEMM_ALIGN_EPI, GEMM_SP2>(lds + RING_OFF, g, S, E);
        }
        SEAM(pb + 4);
        if (IN(pb + 5)) {
            pg8::Gemm g{PROJ, (const bf16*)(ws + WS_WDN), M, D, FF}; pg8::StaticOrder S; S.init(M, D, G, (int)blockIdx.x, WGM_RES); S.rev = DOWN_REV;
            if constexpr (FUSE_T && L == DEPTH - 1) {
                pg8::EpiFinal E{XB, SSQ + (size_t)(2 * L + 2) * M, (unsigned*)(ctl + CW_FIN), args.in[14], args.out, D};
                pg8::gemm_phase<pg8::EpiFinal, pg8::StaticOrder, GEMM_ALIGN_EPI, GEMM_SP2>(lds + RING_OFF, g, S, E);
            } else {
            pg8::EpiResid E{XB, SSQ + (size_t)(2 * L + 2) * M, D, 1.0f};
            pg8::gemm_phase<pg8::EpiResid, pg8::StaticOrder, GEMM_ALIGN_EPI, GEMM_SP2>(lds + RING_OFF, g, S, E);
            }
        }
        if (!(FUSE_T && L == DEPTH - 1)) SEAM(pb + 5);
    }
    if (!FUSE_T && IN(N_PHASES - 1)) {
        final_norm(args.out, XB, SSQ + (size_t)8 * M, args.in[14], gw, NGW, lane);
    }
#undef IN
#undef SEAM
}

extern "C" void kernel_launch(void* const* d_in, const int* in_sizes, int n_in, void* d_out, int out_size, void* d_ws, size_t ws_size, hipStream_t stream) {
    static int grid = 0; static bool fuse = false;
    if (grid == 0) {
        if (n_in != 15 || in_sizes[0] != M_PROMPT * D || in_sizes[1] != M_SAMPLE * D || out_size != M * D || ws_size < WS_END) {
            fprintf(stderr, "kernel_launch: unexpected shapes / workspace (n_in %d, out %d, ws %zu, need %zu); nothing launched\n", n_in, out_size, ws_size, (size_t)WS_END); grid = -1; return; }
        int dev = 0, cus = 0, per_cu = 0;
        if (hipGetDevice(&dev) != hipSuccess || hipDeviceGetAttribute(&cus, hipDeviceAttributeMultiprocessorCount, dev) != hipSuccess) { fprintf(stderr, "kernel_launch: device query failed\n"); grid = -1; return; }
        fuse = FUSE_FINAL && cus >= 249;
        const void* kf = fuse ? (const void*)enc_fwd<true> : (const void*)enc_fwd<false>;
        if (hipFuncSetAttribute(kf, hipFuncAttributeMaxDynamicSharedMemorySize, LDS_BYTES) != hipSuccess) { fprintf(stderr, "kernel_launch: hipFuncSetAttribute failed\n"); grid = -1; return; }
        if (hipOccupancyMaxActiveBlocksPerMultiprocessor(&per_cu, kf, NWAVES * 64, LDS_BYTES) != hipSuccess || per_cu < 1) {
            fprintf(stderr, "kernel_launch: occupancy query reports %d workgroups per CU; nothing launched\n", per_cu); (void)hipGetLastError(); grid = -1; return; }
        grid = cus;
    }
    if (grid < 0) return;
    if (hipMemsetAsync((char*)d_ws + WS_CTL, 0, CTL_ZERO_BYTES, stream) != hipSuccess) { fprintf(stderr, "kernel_launch: hipMemsetAsync failed\n"); return; }
    Args a{};
    for (int i = 0; i < 15; ++i) a.in[i] = (const float*)d_in[i];
    a.out = (float*)d_out; a.ws = (unsigned char*)d_ws;
    if (PER_PHASE_LAUNCH) {
        for (int p = 0; p < N_PHASES; ++p) { a.ph_lo = p; a.ph_hi = p + 1; hipLaunchKernelGGL(enc_fwd<false>, dim3(grid), dim3(NWAVES * 64), LDS_BYTES, stream, a); }
    } else {
        a.ph_lo = 0; a.ph_hi = N_PHASES;
        if (fuse) hipLaunchKernelGGL(enc_fwd<true>, dim3(grid), dim3(NWAVES * 64), LDS_BYTES, stream, a);
        else hipLaunchKernelGGL(enc_fwd<false>, dim3(grid), dim3(NWAVES * 64), LDS_BYTES, stream, a);
    }
    const hipError_t le = hipPeekAtLastError();
    if (le != hipSuccess) fprintf(stderr, "kernel_launch: launch failed: %s\n", hipGetErrorName(le));
}
```

```cpp
#ifndef GEMM_SERPENTINE
#define GEMM_SERPENTINE 0
#endif
#ifndef FUSE_FINAL
#define FUSE_FINAL 1
#endif
#ifndef NAP_L0
#define NAP_L0 0
#endif
#ifndef PROJ_HM
#define PROJ_HM 1
#endif
#ifndef ATT_FIRST
#define ATT_FIRST 1
#endif
#ifndef C_RECENT
#define C_RECENT 1
#endif
#ifndef PART_HM
#define PART_HM 1
#endif
#ifndef PROBE_ATOM
#define PROBE_ATOM 1
#endif
#ifndef P0_BURN
#define P0_BURN 0
#endif
#ifndef ATT_A_XPF
#define ATT_A_XPF 0
#endif
#ifndef ZERO_C_FIRST
#define ZERO_C_FIRST 0
#endif
#ifndef ZERO_BY_MFMA
#define ZERO_BY_MFMA 1
#endif
#ifndef EPI_NT_STORES
#define EPI_NT_STORES 0
#endif
#include <hip/hip_runtime.h>
#include <cstdio>
#include <cstdint>
namespace pg8 {
#define PG8_LAS __attribute__((address_space(3)))
typedef unsigned short bf16_t;
typedef short bf16x8 __attribute__((ext_vector_type(8)));
typedef float f32x4 __attribute__((ext_vector_type(4)));
typedef unsigned u32x4 __attribute__((ext_vector_type(4)));
constexpr int BM = 256, BK = 64, HALF = 128, HTB = HALF * BK * 2  , STAGE_BYTES = 8 * HTB, NXCD = 8, WGM = 8;

__host__ __device__ __forceinline__ int lds_byte(int r, int c) { const int st = (r >> 4) * 2 + (c >> 5), rr = r & 15, cc = c & 31, ob = rr * 64 + cc * 2; return st * 1024 + (ob ^ (((ob >> 9) & 1) << 5)); }
__host__ __device__ __forceinline__ void stage_rc(int b, int& R, int& C) { const int st = b / 1024, sb = b % 1024, swz = sb ^ (((sb >> 9) & 1) << 5); R = (st >> 1) * 16 + swz / 64; C = (st & 1) * 32 + (swz % 64) / 2; }
__host__ __device__ __forceinline__ int perm32(int rho) { const int n = rho >> 4, i = rho & 15; return 8 * (i >> 2) + 4 * n + (i & 3); }

struct Unit { int pm, pn; };
struct Gemm { const bf16_t* A; const bf16_t* Bt; int M, N, K; };

struct StaticOrder {
    int nM, nN, nwg, G, c, wgm, i0 = 0, i1 = 1 << 30, rev = 0;
    __host__ __device__ void init(int M, int N, int G_, int c_, int wgm_ = WGM) { nM = M / BM; nN = N / BM; nwg = nM * nN; G = G_; c = c_; wgm = wgm_; }
    __host__ __device__ bool next(int i, Unit& u) const {
        if (i + i0 >= i1) return false;
        const long L = (long)(i + i0) * G + c; if (L >= nwg) return false;
        int wgid = (int)L; { const int q = nwg / NXCD, r = nwg % NXCD, xcd = wgid % NXCD; int off = wgid / NXCD; if (rev && r == 0) off = ((q - 1 - off) & ~31) | (off & 31);
            wgid = (xcd < r ? xcd * (q + 1) : r * (q + 1) + (xcd - r) * q) + off; }
        const int nig = wgm * nN, gid = wgid / nig, fm = gid * wgm, gsz = (nM - fm) < wgm ? (nM - fm) : wgm;
        u.pm = fm + ((wgid % nig) % gsz); u.pn = (wgid % nig) / gsz; return true;
    }
    __device__ __forceinline__ void a_ready(const Unit&) const {}
    __device__ __forceinline__ void done(const Unit&) const {}
};

__device__ __forceinline__ unsigned cvt_pk_bf16(float lo, float hi) { unsigned r; asm volatile("v_cvt_pk_bf16_f32 %0, %1, %2" : "=v"(r) : "v"(lo), "v"(hi)); return r; }
typedef unsigned long long u64;
constexpr float RMS_EPS_F = 1e-6f, SSQ_FIX = 1048576.0f;
struct RowSsq { u64 v[8]; };
__device__ __forceinline__ RowSsq ssq_rows(const u64* ssq, int row0) { RowSsq r;
#pragma unroll
    for (int it = 0; it < 8; ++it) r.v[it] = ssq[row0 + (it >> 2) * HALF + (it & 3) * 16];
    return r; }
__device__ __forceinline__ float u64_to_f32(u64 v) { return (float)(unsigned)(v >> 32) * 4294967296.0f + (float)(unsigned)v; }
__device__ __forceinline__ float rstd_from(u64 v) { return __builtin_amdgcn_rsqf(u64_to_f32(v) * (1.0f / (2048.0f * SSQ_FIX)) + RMS_EPS_F); }
__device__ __forceinline__ float rstd_of(const u64* ssq, int row) { return rstd_from(ssq[row]); }

#if EPI_NT_STORES
#define EPI_STORE16(p, v) __builtin_nontemporal_store((v), (u32x4*)(p))
#else
#define EPI_STORE16(p, v) (*(u32x4*)(p) = (v))
#endif
struct EpiProj {
    static constexpr bool PERM = true, AFTER_DRAIN = false;
    bf16_t* O; int ldc; const u64* ssq; int permg;
    typedef RowSsq Pre;
    __device__ __forceinline__ Pre prefetch(const Unit& u, int wr, int, int fr, int) const { return ssq_rows(ssq, u.pm * BM + wr * 64 + fr); }
    __device__ __forceinline__ void operator()(const f32x4 (&acc)[2][2][4][2], const Unit& u, int wr, int wc, int fr, int fq, const Pre& pre) const {
        const int row0 = u.pm * BM + wr * 64 + fr, col0 = u.pn * BM + wc * 32 + 8 * fq;
        const int r256_ = u.pm * BM, ldm_ = 49152;
        const int T_ = r256_ < 16384 ? 4096 : 8192, sb_ = r256_ < 16384 ? (r256_ & ~4095) : 16384 + ((r256_ - 16384) & ~8191);
        (void)T_; (void)sb_; (void)ldm_; (void)col0;
        float rsv[8];
#pragma unroll
        for (int it = 0; it < 8; ++it) rsv[it] = rstd_from(pre.v[it]);
#pragma unroll
        for (int ai = 0; ai < 2; ++ai)
#pragma unroll
            for (int m = 0; m < 4; ++m) { const int row = row0 + ai * HALF + m * 16; const float rs = rsv[ai * 4 + m];
#if PROJ_HM
                int rowq = row;
                if (u.pn < 6 * permg) { const int sh = 2 * (u.pn / 6), tl = row - sb_; rowq = sb_ + (tl & ((1 << sh) - 1)) * (T_ >> sh) + (tl >> sh); }
                bf16_t* rowp = O + ((size_t)(u.pn * 2) * (size_t)ldm_ + rowq) * 128 + wc * 32 + 8 * fq; const size_t bjs = (size_t)ldm_ * 128;
#else
                bf16_t* rowp = O + (size_t)row * ldc + col0; const size_t bjs = HALF;
#endif
#pragma unroll
                for (int bj = 0; bj < 2; ++bj) { const f32x4 v0 = acc[ai][bj][m][0] * rs, v1 = acc[ai][bj][m][1] * rs;
                    u32x4 w; w.x = cvt_pk_bf16(v0[0], v0[1]); w.y = cvt_pk_bf16(v0[2], v0[3]); w.z = cvt_pk_bf16(v1[0], v1[1]); w.w = cvt_pk_bf16(v1[2], v1[3]);
                    EPI_STORE16(rowp + bj * bjs, w); } }
    }
};
struct EpiResid {
    static constexpr bool PERM = true, AFTER_DRAIN = false;
    bf16_t* XB; u64* ssq_out; int ldc; float scale; bool atom = true;
    static constexpr int NPRE = 2;
    struct Pre { u32x4 x[NPRE][2]; };
    __device__ __forceinline__ Pre prefetch(const Unit& u, int wr, int wc, int fr, int fq) const { Pre P; const int row0 = u.pm * BM + wr * 64 + fr, col0 = u.pn * BM + wc * 32 + 8 * fq;
#pragma unroll
        for (int it = 0; it < NPRE; ++it) { const bf16_t* xp = XB + (size_t)(row0 + (it >> 2) * HALF + (it & 3) * 16) * ldc + col0; P.x[it][0] = *(const u32x4*)(xp); P.x[it][1] = *(const u32x4*)(xp + HALF); }
        return P; }
    __device__ __forceinline__ void operator()(const f32x4 (&acc)[2][2][4][2], const Unit& u, int wr, int wc, int fr, int fq, const Pre& pre) const {
        const int row0 = u.pm * BM + wr * 64 + fr, col0 = u.pn * BM + wc * 32 + 8 * fq;
        constexpr int WIN = 4;
        u32x4 xin[8][2];
#define RES_LOAD(it_) do { const bf16_t* xp_ = XB + (size_t)(row0 + ((it_) >> 2) * HALF + ((it_) & 3) * 16) * ldc + col0; \
            xin[it_][0] = *(const u32x4*)(xp_); xin[it_][1] = *(const u32x4*)(xp_ + HALF); } while (0)
#pragma unroll
        for (int it = 0; it < NPRE; ++it) { xin[it][0] = pre.x[it][0]; xin[it][1] = pre.x[it][1]; }
#pragma unroll
        for (int it = NPRE; it < NPRE + WIN; ++it) RES_LOAD(it);
#pragma unroll
        for (int it = 0; it < 8; ++it) {
            if (it + NPRE + WIN < 8) RES_LOAD(it + NPRE + WIN);
            const int ai = it >> 2, m = it & 3, row = row0 + ai * HALF + m * 16; bf16_t* bp = XB + (size_t)row * ldc + col0; float part = 0.f;
#pragma unroll
            for (int bj = 0; bj < 2; ++bj) { const u32x4 xo = xin[it][bj];
                f32x4 v0, v1;
                v0[0] = __builtin_bit_cast(float, xo.x << 16); v0[1] = __builtin_bit_cast(float, xo.x & 0xffff0000u); v0[2] = __builtin_bit_cast(float, xo.y << 16); v0[3] = __builtin_bit_cast(float, xo.y & 0xffff0000u);
                v1[0] = __builtin_bit_cast(float, xo.z << 16); v1[1] = __builtin_bit_cast(float, xo.z & 0xffff0000u); v1[2] = __builtin_bit_cast(float, xo.w << 16); v1[3] = __builtin_bit_cast(float, xo.w & 0xffff0000u);
                v0 = v0 + acc[ai][bj][m][0] * scale; v1 = v1 + acc[ai][bj][m][1] * scale;
                part += (v0[0] * v0[0] + v0[1] * v0[1]) + (v0[2] * v0[2] + v0[3] * v0[3]) + (v1[0] * v1[0] + v1[1] * v1[1]) + (v1[2] * v1[2] + v1[3] * v1[3]);
                u32x4 w; w.x = cvt_pk_bf16(v0[0], v0[1]); w.y = cvt_pk_bf16(v0[2], v0[3]); w.z = cvt_pk_bf16(v1[0], v1[1]); w.w = cvt_pk_bf16(v1[2], v1[3]);
                *(u32x4*)(bp + bj * HALF) = w; }
            part += __shfl_xor(part, 16); part += __shfl_xor(part, 32);
            if (fq == 0 && atom) atomicAdd(ssq_out + row, (u64)(part * SSQ_FIX));
            asm volatile("" ::: "memory"); }
#undef RES_LOAD
    }
};
struct EpiFinal {
    static constexpr bool PERM = true, AFTER_DRAIN = false;
    const bf16_t* XB; u64* ssq_out; unsigned* cnt; const float* gain; float* out; int ldc;
    static constexpr int NPRE = EpiResid::NPRE;
    typedef EpiResid::Pre Pre;
    __device__ __forceinline__ Pre prefetch(const Unit& u, int wr, int wc, int fr, int fq) const { Pre P; const int row0 = u.pm * BM + wr * 64 + fr, col0 = u.pn * BM + wc * 32 + 8 * fq;
#pragma unroll
        for (int it = 0; it < NPRE; ++it) { const bf16_t* xp = XB + (size_t)(row0 + (it >> 2) * HALF + (it & 3) * 16) * ldc + col0; P.x[it][0] = *(const u32x4*)(xp); P.x[it][1] = *(const u32x4*)(xp + HALF); }
        return P; }
    __device__ __forceinline__ void operator()(const f32x4 (&acc)[2][2][4][2], const Unit& u, int wr, int wc, int fr, int fq, const Pre& pre) const {
        const int row0 = u.pm * BM + wr * 64 + fr, col0 = u.pn * BM + wc * 32 + 8 * fq;
        constexpr int WIN = 4;
        u32x4 xin[8][2]; f32x4 xn[8][2][2]; u64 old[8];
#define RES_LOAD(it_) do { const bf16_t* xp_ = XB + (size_t)(row0 + ((it_) >> 2) * HALF + ((it_) & 3) * 16) * ldc + col0; \
            xin[it_][0] = *(const u32x4*)(xp_); xin[it_][1] = *(const u32x4*)(xp_ + HALF); } while (0)
#pragma unroll
        for (int it = 0; it < NPRE; ++it) { xin[it][0] = pre.x[it][0]; xin[it][1] = pre.x[it][1]; }
#pragma unroll
        for (int it = NPRE; it < NPRE + WIN; ++it) RES_LOAD(it);
#pragma unroll
        for (int it = 0; it < 8; ++it) {
            if (it + NPRE + WIN < 8) RES_LOAD(it + NPRE + WIN);
            const int ai = it >> 2, m = it & 3, row = row0 + ai * HALF + m * 16; float part = 0.f;
#pragma unroll
            for (int bj = 0; bj < 2; ++bj) { const u32x4 xo = xin[it][bj];
                f32x4 v0, v1;
                v0[0] = __builtin_bit_cast(float, xo.x << 16); v0[1] = __builtin_bit_cast(float, xo.x & 0xffff0000u); v0[2] = __builtin_bit_cast(float, xo.y << 16); v0[3] = __builtin_bit_cast(float, xo.y & 0xffff0000u);
                v1[0] = __builtin_bit_cast(float, xo.z << 16); v1[1] = __builtin_bit_cast(float, xo.z & 0xffff0000u); v1[2] = __builtin_bit_cast(float, xo.w << 16); v1[3] = __builtin_bit_cast(float, xo.w & 0xffff0000u);
                v0 = v0 + acc[ai][bj][m][0]; v1 = v1 + acc[ai][bj][m][1];
                part += (v0[0] * v0[0] + v0[1] * v0[1]) + (v0[2] * v0[2] + v0[3] * v0[3]) + (v1[0] * v1[0] + v1[1] * v1[1]) + (v1[2] * v1[2] + v1[3] * v1[3]);
                xn[it][bj][0] = v0; xn[it][bj][1] = v1; }
            part += __shfl_xor(part, 16); part += __shfl_xor(part, 32);
            old[it] = 0;
            if (fq == 0) old[it] = __hip_atomic_fetch_add(ssq_out + row, (u64)(part * SSQ_FIX), __ATOMIC_RELAXED, __HIP_MEMORY_SCOPE_AGENT);
            asm volatile("" ::: "memory"); }
#undef RES_LOAD
        f32x4 gv[2][2];
#pragma unroll
        for (int bj = 0; bj < 2; ++bj) { gv[bj][0] = *(const f32x4*)(gain + col0 + bj * HALF); gv[bj][1] = *(const f32x4*)(gain + col0 + bj * HALF + 4); }
#pragma unroll
        for (int it = 0; it < 8; ++it) asm volatile("" :: "v"(old[it]));
        asm volatile("s_waitcnt vmcnt(0)" ::: "memory");
        unsigned* cw = cnt + u.pm * 64;
        if (__builtin_amdgcn_mbcnt_hi(~0u, __builtin_amdgcn_mbcnt_lo(~0u, 0u)) == 0) __hip_atomic_fetch_add(cw, 1u, __ATOMIC_RELAXED, __HIP_MEMORY_SCOPE_AGENT);
        asm volatile("" ::: "memory");
        for (unsigned spins = 0; __hip_atomic_load(cw, __ATOMIC_RELAXED, __HIP_MEMORY_SCOPE_AGENT) < 64u && spins < (1u << 20); ++spins) __builtin_amdgcn_s_sleep(4);
        asm volatile("" ::: "memory");
        u64 sv[8];
#pragma unroll
        for (int it = 0; it < 8; ++it) sv[it] = __hip_atomic_load(ssq_out + row0 + (it >> 2) * HALF + (it & 3) * 16, __ATOMIC_RELAXED, __HIP_MEMORY_SCOPE_AGENT);
#pragma unroll
        for (int it = 0; it < 8; ++it) { const int row = row0 + (it >> 2) * HALF + (it & 3) * 16; const float rs = rstd_from(sv[it]); float* op = out + (size_t)row * ldc + col0;
#pragma unroll
            for (int bj = 0; bj < 2; ++bj) { *(f32x4*)(op + bj * HALF) = xn[it][bj][0] * rs * gv[bj][0]; *(f32x4*)(op + bj * HALF + 4) = xn[it][bj][1] * rs * gv[bj][1]; } }
    }
};
struct EpiGateUp {
    static constexpr bool PERM = true, AFTER_DRAIN = false;
    bf16_t* O; int ldc; const u64* ssq;
    typedef RowSsq Pre;
    __device__ __forceinline__ Pre prefetch(const Unit& u, int wr, int, int fr, int) const { return ssq_rows(ssq, u.pm * BM + wr * 64 + fr); }
    __device__ __forceinline__ static float silu_mul(float g, float uu) { const float e = __builtin_amdgcn_exp2f(g * -1.4426950408889634f); return g * __builtin_amdgcn_rcpf(1.0f + e) * uu; }
    __device__ __forceinline__ void operator()(const f32x4 (&acc)[2][2][4][2], const Unit& u, int wr, int wc, int fr, int fq, const Pre& pre) const {
        const int row0 = u.pm * BM + wr * 64 + fr, col0 = u.pn * HALF + wc * 32 + 8 * fq;
        float rsv[8];
#pragma unroll
        for (int it = 0; it < 8; ++it) rsv[it] = rstd_from(pre.v[it]);
#pragma unroll
        for (int ai = 0; ai < 2; ++ai)
#pragma unroll
            for (int m = 0; m < 4; ++m) { const int row = row0 + ai * HALF + m * 16; const float rs = rsv[ai * 4 + m];
                const float cexp = rs * -1.4426950408889634f, rs2 = rs * rs;
                const f32x4 ga = acc[ai][0][m][0], gb = acc[ai][0][m][1];
                const f32x4 ta = ga * acc[ai][1][m][0], tb = gb * acc[ai][1][m][1], xa = ga * cexp, xb = gb * cexp;
                f32x4 da, db;
#pragma unroll
                for (int j = 0; j < 4; ++j) { da[j] = __builtin_amdgcn_exp2f(xa[j]); db[j] = __builtin_amdgcn_exp2f(xb[j]); }
                da = da + 1.0f; db = db + 1.0f;
#pragma unroll
                for (int j = 0; j < 4; ++j) { da[j] = __builtin_amdgcn_rcpf(da[j]); db[j] = __builtin_amdgcn_rcpf(db[j]); }
                const f32x4 oa = ta * da * rs2, ob = tb * db * rs2;
                u32x4 w; w.x = cvt_pk_bf16(oa[0], oa[1]); w.y = cvt_pk_bf16(oa[2], oa[3]); w.z = cvt_pk_bf16(ob[0], ob[1]); w.w = cvt_pk_bf16(ob[2], ob[3]);
                EPI_STORE16(O + (size_t)row * ldc + col0, w); }
    }
};

template <class Epi, class Sched, bool ALIGN_EPI = false, bool SP2 = false, int NAP = 0>
__device__ __forceinline__ void gemm_phase(PG8_LAS unsigned char* lds, const Gemm g, const Sched& S, const Epi& E) {
    const int tid = threadIdx.x, wid = __builtin_amdgcn_readfirstlane(tid >> 6), lane = tid & 63, wr = wid >> 2, wc = wid & 3, fr = lane & 15, fq = lane >> 4;
    const int K = g.K, nt = K / BK;
    unsigned voffA[2], voffB[2];
#pragma unroll
    for (int i = 0; i < 2; ++i) { int R, C; stage_rc(tid * 16 + i * 8192, R, C); const int Rb = Epi::PERM ? ((R & ~31) + perm32(R & 31)) : R;
        voffA[i] = (unsigned)(R * K + C) * 2u; voffB[i] = (unsigned)(Rb * K + C) * 2u; }
    constexpr ptrdiff_t KS = BK * 2;
#define PG8_DIR(i_) (GEMM_SERPENTINE && ((i_) & 1))
    const size_t hstep = (size_t)HALF * K * 2;
    const size_t tstep = 2 * hstep;
    const unsigned ldsw = (unsigned)wid * 1024u;
    const int aoff = lds_byte(wr * 64 + fr, fq * 8), boff = lds_byte(wc * 32 + fr, fq * 8);
#define PG8_SA(b, h) (((b) * 2 + (h)) * HTB)
#define PG8_SB(b, h) ((4 + (b) * 2 + (h)) * HTB)
#define PG8_STAGE(bufoff, gbase, voff) do { _Pragma("unroll") for (int _i = 0; _i < 2; ++_i) \
        __builtin_amdgcn_global_load_lds((const unsigned*)((const char*)(gbase) + (voff)[_i]), (PG8_LAS unsigned*)(lds + (bufoff) + ldsw + _i * 8192), 16, 0, 0); } while (0)
#define PG8_LDA(dst, b, h) do { _Pragma("unroll") for (int m = 0; m < 4; ++m) _Pragma("unroll") for (int k = 0; k < 2; ++k) dst[m][k] = *(const PG8_LAS bf16x8*)(lds + PG8_SA(b, h) + aoff + m * 2048 + k * 1024); } while (0)
#define PG8_LDB(dst, b, h) do { _Pragma("unroll") for (int n = 0; n < 2; ++n) _Pragma("unroll") for (int k = 0; k < 2; ++k) dst[n][k] = *(const PG8_LAS bf16x8*)(lds + PG8_SB(b, h) + boff + n * 2048 + k * 1024); } while (0)
#define PG8_MMA(ai, bj, At, Bt) do { __builtin_amdgcn_s_setprio(1); _Pragma("unroll") for (int m = 0; m < 4; ++m) _Pragma("unroll") for (int n = 0; n < 2; ++n) _Pragma("unroll") for (int k = 0; k < 2; ++k) \
        acc[ai][bj][m][n] = __builtin_amdgcn_mfma_f32_16x16x32_bf16(Bt[n][k], At[m][k], acc[ai][bj][m][n], 0, 0, 0); __builtin_amdgcn_s_setprio(0); } while (0)
#define PG8_WAIT_V(n) asm volatile("s_waitcnt vmcnt(" #n ")" ::: "memory")
#define PG8_WAIT_L(n) asm volatile("s_waitcnt lgkmcnt(" #n ")" ::: "memory")
#define PG8_BAR __builtin_amdgcn_s_barrier()
#define PG8_SCHED __builtin_amdgcn_sched_barrier(0)
    Unit cur, nxt; int ui = 0;
    if (!S.next(0, cur)) return;
    f32x4 acc[2][2][4][2];
#pragma unroll
    for (int a = 0; a < 2; ++a)
#pragma unroll
        for (int b = 0; b < 2; ++b)
#pragma unroll
            for (int m = 0; m < 4; ++m)
#pragma unroll
                for (int n = 0; n < 2; ++n) acc[a][b][m][n] = (f32x4){0.f, 0.f, 0.f, 0.f};
    bf16x8 At[4][2], B0[2][2], B1[2][2];
    ptrdiff_t kstep = PG8_DIR(0) ? -KS : KS;
    const char* cA = (const char*)g.A + (size_t)cur.pm * tstep + (PG8_DIR(0) ? (ptrdiff_t)(nt - 1) * KS : 0); const char* cB = (const char*)g.Bt + (size_t)cur.pn * tstep + (PG8_DIR(0) ? (ptrdiff_t)(nt - 1) * KS : 0);
    S.a_ready(cur);
    typename Epi::Pre pre = E.prefetch(cur, wr, wc, fr, fq);
    if constexpr (SP2) {
        PG8_STAGE(PG8_SB(0, 0), cB, voffB); PG8_STAGE(PG8_SB(0, 1), cB + hstep, voffB); PG8_STAGE(PG8_SA(0, 0), cA, voffA); PG8_STAGE(PG8_SA(0, 1), cA + hstep, voffA);
        if (wr == 1) PG8_BAR;
        PG8_WAIT_V(2); PG8_BAR;
        PG8_STAGE(PG8_SB(1, 0), cB + kstep, voffB); PG8_STAGE(PG8_SA(1, 0), cA + kstep, voffA); PG8_STAGE(PG8_SB(1, 1), cB + hstep + kstep, voffB);
        PG8_WAIT_V(6); PG8_BAR;
    } else {
        PG8_STAGE(PG8_SB(0, 0), cB, voffB); PG8_STAGE(PG8_SA(0, 0), cA, voffA); PG8_STAGE(PG8_SB(0, 1), cB + hstep, voffB); PG8_STAGE(PG8_SA(0, 1), cA + hstep, voffA);
        if (wr == 1) PG8_BAR;
        PG8_WAIT_V(4); PG8_BAR;
        PG8_STAGE(PG8_SB(1, 0), cB + kstep, voffB); PG8_STAGE(PG8_SA(1, 0), cA + kstep, voffA); PG8_STAGE(PG8_SB(1, 1), cB + hstep + kstep, voffB);
        PG8_WAIT_V(6); PG8_BAR;
    }
    for (;;) {
        const bool has_next = S.next(ui + 1, nxt);
        const bool ndir = PG8_DIR(ui + 1); const ptrdiff_t nks = has_next ? (ndir ? -KS : KS) : kstep, noff = ndir ? (ptrdiff_t)(nt - 1) * KS : 0;
        const char* nA = has_next ? (const char*)g.A + (size_t)nxt.pm * tstep + noff : cA; const char* nB = has_next ? (const char*)g.Bt + (size_t)nxt.pn * tstep + noff : cB;
        for (int t = 0; t < nt; t += 2) {
            const bool last = (t == nt - 2);
            if constexpr (NAP > 0) __builtin_amdgcn_s_sleep(NAP);
            const char* a1 = cA + (ptrdiff_t)(t + 1) * kstep;
            const char* a2 = last ? nA : cA + (ptrdiff_t)(t + 2) * kstep; const char* b2 = last ? nB : cB + (ptrdiff_t)(t + 2) * kstep;
            const ptrdiff_t ks3 = last ? nks : kstep; const char* a3 = a2 + ks3; const char* b3 = b2 + ks3;
            if (last && has_next) S.a_ready(nxt);
            if constexpr (SP2) {
            PG8_LDB(B0, 0, 0); PG8_LDB(B1, 0, 1); PG8_SCHED; PG8_LDA(At, 0, 0); PG8_STAGE(PG8_SA(1, 1), a1 + hstep, voffA);
            PG8_WAIT_V(8); PG8_WAIT_L(0); PG8_BAR; PG8_MMA(0, 0, At, B0); PG8_MMA(0, 1, At, B1); PG8_BAR; PG8_SCHED;
            PG8_LDA(At, 0, 1); PG8_STAGE(PG8_SB(0, 0), b2, voffB); PG8_STAGE(PG8_SB(0, 1), b2 + hstep, voffB); PG8_STAGE(PG8_SA(0, 0), a2, voffA);
            PG8_WAIT_V(8); PG8_WAIT_L(0); PG8_BAR; PG8_MMA(1, 0, At, B0); PG8_MMA(1, 1, At, B1); PG8_BAR; PG8_SCHED;
            PG8_LDB(B0, 1, 0); PG8_LDB(B1, 1, 1); PG8_SCHED; PG8_LDA(At, 1, 0); PG8_STAGE(PG8_SA(0, 1), a2 + hstep, voffA);
            PG8_WAIT_V(8); PG8_WAIT_L(0); PG8_BAR; PG8_MMA(0, 0, At, B0); PG8_MMA(0, 1, At, B1); PG8_BAR; PG8_SCHED;
            PG8_LDA(At, 1, 1); PG8_STAGE(PG8_SB(1, 0), b3, voffB); PG8_STAGE(PG8_SB(1, 1), b3 + hstep, voffB); PG8_STAGE(PG8_SA(1, 0), a3, voffA);
            PG8_WAIT_V(8); PG8_WAIT_L(0); PG8_BAR; PG8_MMA(1, 0, At, B0); PG8_MMA(1, 1, At, B1); PG8_BAR; PG8_SCHED;
            } else {
            PG8_LDB(B0, 0, 0); PG8_SCHED; PG8_LDA(At, 0, 0); PG8_STAGE(PG8_SA(1, 1), a1 + hstep, voffA);
            PG8_WAIT_L(8); PG8_BAR; PG8_WAIT_L(0); PG8_MMA(0, 0, At, B0); PG8_BAR; PG8_SCHED;
            PG8_LDB(B1, 0, 1); PG8_STAGE(PG8_SB(0, 0), b2, voffB);
            PG8_BAR; PG8_WAIT_L(0); PG8_MMA(0, 1, At, B1); PG8_BAR;
            PG8_LDA(At, 0, 1); PG8_STAGE(PG8_SA(0, 0), a2, voffA);
            PG8_BAR; PG8_WAIT_L(0); PG8_MMA(1, 0, At, B0); PG8_BAR; PG8_SCHED;
            PG8_STAGE(PG8_SB(0, 1), b2 + hstep, voffB);
            PG8_WAIT_V(6); PG8_BAR; PG8_MMA(1, 1, At, B1); PG8_BAR;
            PG8_LDB(B0, 1, 0); PG8_SCHED; PG8_LDA(At, 1, 0); PG8_STAGE(PG8_SA(0, 1), a2 + hstep, voffA);
            PG8_WAIT_L(8); PG8_BAR; PG8_WAIT_L(0); PG8_MMA(0, 0, At, B0); PG8_BAR; PG8_SCHED;
            PG8_LDB(B1, 1, 1); PG8_STAGE(PG8_SB(1, 0), b3, voffB);
            PG8_BAR; PG8_WAIT_L(0); PG8_MMA(0, 1, At, B1); PG8_BAR;
            PG8_LDA(At, 1, 1); PG8_STAGE(PG8_SA(1, 0), a3, voffA);
            PG8_BAR; PG8_WAIT_L(0); PG8_MMA(1, 0, At, B0); PG8_BAR; PG8_SCHED;
            PG8_STAGE(PG8_SB(1, 1), b3 + hstep, voffB);
            PG8_WAIT_V(6); PG8_BAR; PG8_MMA(1, 1, At, B1); PG8_BAR;
            }
        }
        if constexpr (ALIGN_EPI) { if (wr == 0) PG8_BAR; }
        if constexpr (!Epi::AFTER_DRAIN) { E(acc, cur, wr, wc, fr, fq, pre); S.done(cur); }
        if (!has_next) break;
#if ZERO_BY_MFMA
        { bf16x8 zb = {}; asm volatile("" : "+v"(zb));
#pragma unroll
        for (int a = 0; a < 2; ++a)
#pragma unroll
            for (int b = 0; b < 2; ++b)
#pragma unroll
                for (int m = 0; m < 4; ++m)
#pragma unroll
                    for (int n = 0; n < 2; ++n) acc[a][b][m][n] = __builtin_amdgcn_mfma_f32_16x16x32_bf16(zb, zb, (f32x4){0.f, 0.f, 0.f, 0.f}, 0, 0, 0); }
#else
#pragma unroll
        for (int a = 0; a < 2; ++a)
#pragma unroll
            for (int b = 0; b < 2; ++b)
#pragma unroll
                for (int m = 0; m < 4; ++m)
#pragma unroll
                    for (int n = 0; n < 2; ++n) acc[a][b][m][n] = (f32x4){0.f, 0.f, 0.f, 0.f};
#endif
        cur = nxt; cA = nA; cB = nB; kstep = nks; ++ui;
        pre = E.prefetch(cur, wr, wc, fr, fq);
        if constexpr (ALIGN_EPI) { if (wr == 1) PG8_BAR; }
    }
    PG8_WAIT_V(0);
    if constexpr (!ALIGN_EPI) { if (wr == 0) PG8_BAR; }
    PG8_BAR;
    if constexpr (Epi::AFTER_DRAIN) { E.fused(acc, cur, wr, wc, fr, fq, lds, wid, lane); S.done(cur); }
#undef PG8_DIR
#undef PG8_SA
#undef PG8_SB
#undef PG8_STAGE
#undef PG8_LDA
#undef PG8_LDB
#undef PG8_MMA
#undef PG8_WAIT_V
#undef PG8_WAIT_L
#undef PG8_BAR
#undef PG8_SCHED
}
}

constexpr int NWAVES = 8;
#ifndef MK_PER_PHASE
#define MK_PER_PHASE 0
#endif
constexpr bool PER_PHASE_LAUNCH = MK_PER_PHASE != 0;
#ifndef ATT_ROWS_PD
#define ATT_ROWS_PD 3
#endif
#ifndef ATT_STATIC_PRIO
#define ATT_STATIC_PRIO 0
#endif
#ifndef ATT_DMA
#define ATT_DMA 1
#endif
#ifndef ATT_A_WG
#define ATT_A_WG 0
#endif
#ifndef ATT_B_WG
#define ATT_B_WG 1
#endif
#ifndef ATT_C_WG
#define ATT_C_WG 1
#endif
#ifndef GEMM_SP2
#define GEMM_SP2 true
#endif
#ifndef GEMM_ALIGN_EPI
#define GEMM_ALIGN_EPI true
#endif
#ifndef DOWN_REV
#define DOWN_REV 0
#endif
#ifndef WGM_RES
#define WGM_RES 4
#endif
#ifndef WGM_WIDE
#define WGM_WIDE 8
#endif

constexpr int D = 2048, FF = 5632, NGU = 2 * FF, NPROJ = 6144, DEPTH = 4;
constexpr int M_PROMPT = 4 * 4096, M_SAMPLE = 4 * 8192, M = M_PROMPT + M_SAMPLE;
constexpr int N_PHASES = 2 + 6 * DEPTH;
constexpr float SM_SCALE = 0.08838834764831845f, LOG2E = 1.4426950408889634f;

constexpr size_t MiB = 1u << 20;
constexpr size_t WS_CTL = 0, CTL_ZERO_BYTES = 5 * MiB;
constexpr size_t WS_LSE = 5 * MiB;
constexpr size_t WS_SSQ = 1 * MiB;
constexpr size_t WS_WIN = 8 * MiB, WS_WOUT = 32 * MiB, WS_WGU = 40 * MiB, WS_WDN = 84 * MiB;
constexpr size_t WS_XB = 108 * MiB;
constexpr size_t WS_MIX = 300 * MiB;
constexpr size_t WS_PROJ = 492 * MiB;
constexpr size_t WS_END = 1068 * MiB;
static_assert(WS_SSQ + 10ull * M * 8 <= WS_LSE && WS_SSQ + 10ull * M * 8 <= CTL_ZERO_BYTES && WS_LSE >= CTL_ZERO_BYTES && WS_LSE + 12ull * M * 4 <= WS_WIN && WS_WIN + (size_t)NPROJ * D * 2 <= WS_WOUT && WS_WOUT + (size_t)D * D * 2 <= WS_WGU && WS_WGU + (size_t)NGU * D * 2 <= WS_WDN &&
              WS_WDN + (size_t)D * FF * 2 <= WS_XB && WS_XB + (size_t)M * D * 2 <= WS_MIX && WS_MIX + (size_t)M * D * 2 <= WS_PROJ && WS_PROJ + (size_t)M * NPROJ * 2 <= WS_END, "d_ws map");
#if PROJ_HM
constexpr int PRS = 128;
#define PSLOT(slot) ((size_t)(slot) * ((size_t)M * 128))
#else
constexpr int PRS = NPROJ;
#define PSLOT(slot) ((size_t)(slot) * 128)
#endif
constexpr int CW_FIN = 65536;
constexpr int CW_BAR = 4096;

constexpr int RING_OFF = 0, RING_BYTES = 131072;
constexpr int LDSCTL_OFF = RING_BYTES, MISC_OFF = LDSCTL_OFF + 320;
constexpr int LDS_BYTES = 163840;
static_assert(MISC_OFF + 128 <= LDS_BYTES, "LDS map");

#define GAS __attribute__((address_space(1)))
#define LAS __attribute__((address_space(3)))
typedef unsigned short bf16;
typedef unsigned v4u __attribute__((ext_vector_type(4)));
typedef unsigned v2u __attribute__((ext_vector_type(2)));
typedef float f32x4 __attribute__((ext_vector_type(4)));
typedef GAS unsigned gu32;
#define RLX_AGENT __ATOMIC_RELAXED, __HIP_MEMORY_SCOPE_AGENT
#define LDS_WAIT() asm volatile("s_waitcnt lgkmcnt(0)" ::: "memory")
#define VM_WAIT() asm volatile("s_waitcnt vmcnt(0)" ::: "memory")
__device__ __forceinline__ unsigned f2bf(float f) { unsigned u = __builtin_bit_cast(unsigned, f); return (u + 0x7fffu + ((u >> 16) & 1u)) >> 16; }
__device__ __forceinline__ unsigned pk2(float lo, float hi) { return f2bf(lo) | (f2bf(hi) << 16); }
__device__ __forceinline__ float bf_lo(unsigned w) { return __builtin_bit_cast(float, w << 16); }
__device__ __forceinline__ float bf_hi(unsigned w) { return __builtin_bit_cast(float, w & 0xffff0000u); }

#define XB_TMO      128
#define XB_XCNT(j)  (256  + 64 * (j))
#define XB_XSUB(j)  (1280 + 64 * (j))
#define XB_XGEN(j)  (2304 + 64 * (j))
#define XB_TOP      3328
#define XB_TOPGEN   3392
#define XCD_BAR_WORDS 3456
#define XB_SPIN_CAP (1u << 18)

__device__ __forceinline__ unsigned xb_ld(unsigned* p)              { return __hip_atomic_load(p, __ATOMIC_RELAXED, __HIP_MEMORY_SCOPE_AGENT); }
__device__ __forceinline__ unsigned xb_add(unsigned* p, unsigned v) { return __hip_atomic_fetch_add(p, v, __ATOMIC_RELAXED, __HIP_MEMORY_SCOPE_AGENT); }
__device__ __forceinline__ unsigned xb_xcc_id() { return (unsigned)__builtin_amdgcn_s_getreg((3 << 11) | 20) & 0xFu; }
#define XB_SPIN(cond, bar) do { unsigned _sp = 0; while (cond) { __builtin_amdgcn_s_sleep(1); \
    if ((++_sp & 255u) == 0u) { if (xb_ld(&(bar)[XB_TMO])) break; if (_sp > XB_SPIN_CAP) { atomicAdd(&(bar)[XB_TMO], 1u); break; } } } } while (0)

struct XcdBarrier {
    unsigned* bar; unsigned x;
    volatile LAS unsigned* st;
};

__device__ __forceinline__ XcdBarrier xcd_barrier_post(unsigned* bar, volatile LAS unsigned* st) {
    XcdBarrier b; b.bar = bar; b.x = xb_xcc_id(); b.st = st;
    if (threadIdx.x == 0) (void)xb_add(&bar[XB_XCNT(b.x)], 1u);
    return b;
}
__device__ __forceinline__ void xcd_barrier_complete(unsigned* bar, unsigned x, unsigned& nloc, unsigned& nx) {
    const unsigned G = gridDim.x * gridDim.y * gridDim.z;
    unsigned sum, cnt, mine, sp = 0u;
    for (;;) {
        sum = 0u; cnt = 0u; mine = 0u;
#pragma unroll
        for (unsigned j = 0; j < 16; ++j) { const unsigned c = xb_ld(&bar[XB_XCNT(j)]); sum += c; cnt += (c > 0u) ? 1u : 0u; mine = (j == x) ? c : mine; }
        if (sum == G) break;
        __builtin_amdgcn_s_sleep(1);
        if ((++sp & 255u) == 0u) { if (xb_ld(&bar[XB_TMO])) break; if (sp > XB_SPIN_CAP) { atomicAdd(&bar[XB_TMO], 1u); break; } }
    }
    nloc = mine > 0u ? mine : 1u; nx = cnt > 0u ? cnt : 1u;
}

__device__ __forceinline__ void xcd_barrier(const XcdBarrier& b) {
    asm volatile("s_waitcnt vmcnt(0)" ::: "memory");
    __syncthreads();
    if (threadIdx.x == 0) {
        unsigned* bar = b.bar;
        __builtin_amdgcn_s_waitcnt(0);
        unsigned nloc = b.st[0], nx = b.st[1];
        if (nloc == 0u) { xcd_barrier_complete(bar, b.x, nloc, nx); b.st[0] = nloc; b.st[1] = nx; }
        const unsigned old = xb_add(&bar[XB_XSUB(b.x)], 1u);
        const unsigned gen = old / nloc;
        if (old + 1u == (gen + 1u) * nloc) {
            __builtin_amdgcn_fence(__ATOMIC_RELEASE, "agent");
            asm volatile("s_waitcnt vmcnt(0)" ::: "memory");
            const unsigned og = xb_add(&bar[XB_TOP], 1u);
            const unsigned tg = og / nx;
            if (og + 1u == (tg + 1u) * nx) xb_add(&bar[XB_TOPGEN], 1u);
            else XB_SPIN(xb_ld(&bar[XB_TOPGEN]) == tg, bar);
            __builtin_amdgcn_fence(__ATOMIC_ACQUIRE, "agent");
            xb_add(&bar[XB_XGEN(b.x)], 1u);
            asm volatile("s_waitcnt vmcnt(0)" ::: "memory");
        } else {
            XB_SPIN(xb_ld(&bar[XB_XGEN(b.x)]) == gen, bar);
            __builtin_amdgcn_fence(__ATOMIC_ACQUIRE, "agent");
            asm volatile("s_waitcnt vmcnt(0)" ::: "memory");
        }
    }
    __syncthreads();
}

__device__ __forceinline__ float wave_sum(float v) {
#pragma unroll
    for (int o = 1; o < 64; o <<= 1) v += __shfl_xor(v, o);
    return v;
}
__device__ __forceinline__ void seq_of(int t, int& T, int& sbase) {
    if (t < M_PROMPT) { T = 4096; sbase = t & ~4095; } else { T = 8192; sbase = M_PROMPT + ((t - M_PROMPT) & ~8191); }
}
__device__ __forceinline__ int t5b(int rel) {
    const int n = rel < 0 ? -rel : rel;
    int b = n;
    if (n >= 8) b = 8 + (n >= 15) + (n >= 27) + (n >= 50) + (n >= 91) + (n >= 166) + (n >= 305) + (n >= 559);
    return b + (rel > 0 ? 16 : 0);
}
__device__ __forceinline__ void cvt_load(float (&v)[32], const float* W, int N, int item, int lane) {
    const int nblk = N / 32, kb = item / nblk, nb = item % nblk, k0 = 64 * kb, n0 = 32 * nb;
    const float* p = W + (size_t)(k0 + (lane >> 5)) * N + n0 + (lane & 31);
#pragma unroll
    for (int i = 0; i < 32; ++i) v[i] = p[(size_t)(2 * i) * N];
}
__device__ __forceinline__ void cvt_store(const float (&v)[32], int K, int N, const float* gain, bf16* WT, int mode, LAS float* scr, int item, int lane) {
    const int nblk = N / 32, kb = item / nblk, nb = item % nblk, k0 = 64 * kb, n0 = 32 * nb;
#pragma unroll
    for (int i = 0; i < 32; ++i) { const int kk = 2 * i + (lane >> 5); const float g = gain ? gain[k0 + kk] : 1.0f; scr[kk * 33 + (lane & 31)] = v[i] * g; }
    LDS_WAIT(); asm volatile("" ::: "memory");
    const int d0 = mode == 0 ? n0 : ((n0 >> 7) * 256 + (n0 & 127) + (mode == 2 ? 128 : 0));
    const int c = lane & 7;
#pragma unroll
    for (int j = 0; j < 4; ++j) { const int n = (lane >> 3) + 8 * j; const LAS float* s = scr + (8 * c) * 33 + n;
        v4u o; o.x = pk2(s[0 * 33], s[1 * 33]); o.y = pk2(s[2 * 33], s[3 * 33]); o.z = pk2(s[4 * 33], s[5 * 33]); o.w = pk2(s[6 * 33], s[7 * 33]);
        *(GAS v4u*)(WT + (size_t)(d0 + n) * K + k0 + 8 * c) = o; }
    LDS_WAIT(); asm volatile("" ::: "memory");
}
__device__ __forceinline__ void cvt_matrix(const float* W, int K, int N, const float* gain, bf16* WT, int mode, LAS float* scr, int gw, int NGW, int lane) {
    const int nitems = (K / 64) * (N / 32);
    float va[32], vb[32];
    int it = gw;
    if (it < nitems) cvt_load(va, W, N, it, lane);
    while (it < nitems) {
        const int n1 = it + NGW; if (n1 < nitems) cvt_load(vb, W, N, n1, lane);
        cvt_store(va, K, N, gain, WT, mode, scr, it, lane);
        if (n1 >= nitems) break;
        const int n2 = n1 + NGW; if (n2 < nitems) cvt_load(va, W, N, n2, lane);
        cvt_store(vb, K, N, gain, WT, mode, scr, n1, lane);
        it = n2;
    }
}
struct LayerW { const float* win; const float* wout; int ko; };
__device__ __forceinline__ LayerW layer_w(const float* const* in, int L) {
    LayerW w; const int j = L >> 1;
    if (L & 1) { w.win = in[5] + (size_t)j * D * NPROJ; w.wout = in[6] + (size_t)j * D * D; w.ko = 2048; }
    else { w.win = in[2] + (size_t)j * D * NPROJ; w.wout = in[3] + (size_t)j * 1536 * D; w.ko = 1536; }
    return w;
}
__device__ __forceinline__ void cvt_set(const float* const* in, unsigned char* ws, int which, int Lw, int Lr, LAS float* scr, int gw, int NGW, int lane) {
    const LayerW ww = layer_w(in, Lw), wr = layer_w(in, Lr);
    int rot = 0;
    for (int mi = (which & 1) ? 0 : 1; mi < ((which & 2) ? 5 : 1); ++mi) {
        const float* W; int K, N, mode; const float* gain; bf16* WT;
        if (mi == 0)      { W = ww.win; K = D; N = NPROJ; gain = in[9] + (size_t)Lw * D; WT = (bf16*)(ws + WS_WIN); mode = 0; }
        else if (mi == 1) { W = wr.wout; K = wr.ko; N = D; gain = nullptr; WT = (bf16*)(ws + WS_WOUT); mode = 0; }
        else if (mi == 2) { W = in[11] + (size_t)Lr * D * FF; K = D; N = FF; gain = in[10] + (size_t)Lr * D; WT = (bf16*)(ws + WS_WGU); mode = 1; }
        else if (mi == 3) { W = in[12] + (size_t)Lr * D * FF; K = D; N = FF; gain = in[10] + (size_t)Lr * D; WT = (bf16*)(ws + WS_WGU); mode = 2; }
        else              { W = in[13] + (size_t)Lr * FF * D; K = FF; N = D; gain = nullptr; WT = (bf16*)(ws + WS_WDN); mode = 0; }
        int gwm = gw - rot; gwm += gwm < 0 ? NGW : 0;
        cvt_matrix(W, K, N, gain, WT, mode, scr, gwm, NGW, lane);
        rot = (rot + (K / 64) * (N / 32)) % NGW;
    }
}
__device__ __forceinline__ void prow_load(f32x4 (&v)[8], const float* xp, const float* xs, int row, int lane) {
    const float* src = row < M_PROMPT ? xp + (size_t)row * D : xs + (size_t)(row - M_PROMPT) * D;
    const GAS f32x4* xr = (const GAS f32x4*)src + 2 * lane;
#pragma unroll
    for (int j = 0; j < 4; ++j) { v[2 * j] = xr[128 * j]; v[2 * j + 1] = xr[128 * j + 1]; }
}
__device__ __forceinline__ void prow_store(const f32x4 (&v)[8], bf16* xb, pg8::u64* ssq0, int row, int lane) {
    float s = 0.f;
#pragma unroll
    for (int j = 0; j < 8; ++j) s += (v[j].x * v[j].x + v[j].y * v[j].y) + (v[j].z * v[j].z + v[j].w * v[j].w);
    s = wave_sum(s);
    GAS v4u* brow = (GAS v4u*)(xb + (size_t)row * D) + lane;
#pragma unroll
    for (int j = 0; j < 4; ++j) { v4u w; w.x = pk2(v[2 * j].x, v[2 * j].y); w.y = pk2(v[2 * j].z, v[2 * j].w); w.z = pk2(v[2 * j + 1].x, v[2 * j + 1].y); w.w = pk2(v[2 * j + 1].z, v[2 * j + 1].w); brow[64 * j] = w; }
    if (lane == 0) ssq0[row] = (pg8::u64)(s * pg8::SSQ_FIX);
}
#if P0_BURN
typedef float burn16 __attribute__((ext_vector_type(16)));
__device__ __forceinline__ void mfma_burn(burn16& acc, const f32x4& a, const f32x4& b) {
#pragma unroll 8
    for (int i = 0; i < P0_BURN; ++i) asm volatile("v_mfma_f32_32x32x16_bf16 %0, %1, %2, %0" : "+v"(acc) : "v"(a), "v"(b));
}
#endif
__device__ __forceinline__ void prologue_rows(const float* xp, const float* xs, bf16* xb, pg8::u64* ssq0, int gw, int NGW, int lane) {
    f32x4 va[8], vb[8];
#if P0_BURN
    burn16 bacc; for (int i = 0; i < 16; ++i) bacc[i] = 0.f;
#endif
    int row = gw;
    if (row < M) prow_load(va, xp, xs, row, lane);
    while (row < M) {
        const int r1 = row + NGW; if (r1 < M) prow_load(vb, xp, xs, r1, lane);
        prow_store(va, xb, ssq0, row, lane);
#if P0_BURN
        mfma_burn(bacc, va[0], va[1]);
#endif
        if (r1 >= M) break;
        const int r2 = r1 + NGW; if (r2 < M) prow_load(va, xp, xs, r2, lane);
        prow_store(vb, xb, ssq0, r1, lane);
#if P0_BURN
        mfma_burn(bacc, vb[0], vb[1]);
#endif
        row = r2;
    }
#if P0_BURN
    asm volatile("" :: "v"(bacc));
#endif
}
__device__ __forceinline__ void frow_load(v4u (&w)[4], float& rs, const bf16* xb, const pg8::u64* ssq, int row, int lane) {
    const GAS v4u* brow = (const GAS v4u*)(xb + (size_t)row * D) + lane;
#pragma unroll
    for (int j = 0; j < 4; ++j) w[j] = brow[64 * j];
    rs = pg8::rstd_of(ssq, row);
}
__device__ __forceinline__ void frow_store(const v4u (&w)[4], float rs, const f32x4 (&g)[8], float* out, int row, int lane) {
    GAS f32x4* orow = (GAS f32x4*)(out + (size_t)row * D) + 2 * lane;
#pragma unroll
    for (int j = 0; j < 4; ++j) {
        f32x4 a = {bf_lo(w[j].x), bf_hi(w[j].x), bf_lo(w[j].y), bf_hi(w[j].y)}, b = {bf_lo(w[j].z), bf_hi(w[j].z), bf_lo(w[j].w), bf_hi(w[j].w)};
        orow[128 * j] = a * rs * g[2 * j]; orow[128 * j + 1] = b * rs * g[2 * j + 1]; }
}
__device__ __forceinline__ void final_norm(float* out, const bf16* xb, const pg8::u64* ssq, const float* gain, int gw, int NGW, int lane) {
    f32x4 g[8];
#pragma unroll
    for (int j = 0; j < 4; ++j) { g[2 * j] = ((const GAS f32x4*)gain)[2 * lane + 128 * j]; g[2 * j + 1] = ((const GAS f32x4*)gain)[2 * lane + 128 * j + 1]; }
    v4u wa[4], wb[4]; float ra = 0.f, rb = 0.f;
    int row = gw;
    if (row < M) frow_load(wa, ra, xb, ssq, row, lane);
    while (row < M) {
        const int r1 = row + NGW; if (r1 < M) frow_load(wb, rb, xb, ssq, r1, lane);
        frow_store(wa, ra, g, out, row, lane);
        if (r1 >= M) break;
        const int r2 = r1 + NGW; if (r2 < M) frow_load(wa, ra, xb, ssq, r2, lane);
        frow_store(wb, rb, g, out, r1, lane);
        row = r2;
    }
}

#define ONLINE_STEP(s_, vw_) do { const float mn_ = fmaxf(m, (s_)); const float a_ = __builtin_amdgcn_exp2f(m - mn_), p_ = __builtin_amdgcn_exp2f((s_) - mn_); \
        l = l * a_ + p_; o0 = o0 * a_ + p_ * bf_lo(vw_); o1 = o1 * a_ + p_ * bf_hi(vw_); m = mn_; } while (0)
__device__ __forceinline__ void attn_ab_ref(const bf16* proj, bf16* mixed, const float* t5, const float* sink, int gw, int NGW, int lane) {
    for (int u = gw; u < M * 4; u += NGW) {
        const int t = u >> 2, hs = u & 3; int T, sbase; seq_of(t, T, sbase); const int tl = t - sbase;
        float m = -1e30f, l = 0.f, o0 = 0.f, o1 = 0.f;
        for (int g = 0; g < 3; ++g) {
            const int sh = 2 * g, d = 1 << sh;
            const unsigned qw = ((const unsigned*)(proj + (size_t)t * NPROJ + g * 1536 + hs * 128))[lane];
            const float q0 = bf_lo(qw) * (SM_SCALE * LOG2E), q1 = bf_hi(qw) * (SM_SCALE * LOG2E);
            int jlo = -(tl >> sh), jhi = (T - 1 - tl) >> sh; jlo = jlo < -64 ? -64 : jlo; jhi = jhi > 64 ? 64 : jhi;
            const float* tcol = t5 + g * 4 + hs;
            const bf16* kbase = proj + (size_t)t * NPROJ + g * 1536 + 512 + hs * 128;
#pragma unroll 4
            for (int j = jlo; j <= jhi; ++j) {
                const unsigned* kp = (const unsigned*)(kbase + (ptrdiff_t)(d * j) * NPROJ);
                const unsigned kw = kp[lane], vw = kp[256 + lane];
                const float s = wave_sum(q0 * bf_lo(kw) + q1 * bf_hi(kw)) + tcol[t5b(d * j) * 20] * LOG2E;
                ONLINE_STEP(s, vw);
            }
        }
        const float inv = 1.0f / l;
        ((unsigned*)(mixed + (size_t)t * 1536 + hs * 128))[lane] = pk2(o0 * inv, o1 * inv);
    }
    for (int u = gw; u < M * 8; u += NGW) {
        const int t = u >> 3, h = u & 7, kvh = h >> 2; int T, sbase; seq_of(t, T, sbase); const int tl = t - sbase;
        float m = sink[h] * LOG2E, l = 1.f, o0 = 0.f, o1 = 0.f;
        const unsigned qw = ((const unsigned*)(proj + (size_t)t * NPROJ + 4608 + h * 128))[lane];
        const float q0 = bf_lo(qw) * (SM_SCALE * LOG2E), q1 = bf_hi(qw) * (SM_SCALE * LOG2E);
        int jlo = -tl, jhi = T - 1 - tl; jlo = jlo < -128 ? -128 : jlo; jhi = jhi > 128 ? 128 : jhi;
        const float* tcol = t5 + 12 + h;
        const bf16* kbase = proj + (size_t)t * NPROJ + 4608 + 1024 + kvh * 128;
#pragma unroll 4
        for (int j = jlo; j <= jhi; ++j) {
            const unsigned* kp = (const unsigned*)(kbase + (ptrdiff_t)j * NPROJ);
            const unsigned kw = kp[lane], vw = kp[128 + lane];
            const float s = wave_sum(q0 * bf_lo(kw) + q1 * bf_hi(kw)) + tcol[t5b(j) * 20] * LOG2E;
            ONLINE_STEP(s, vw);
        }
        const float inv = 1.0f / l;
        ((unsigned*)(mixed + (size_t)t * 1536 + 512 + h * 128))[lane] = pk2(o0 * inv, o1 * inv);
    }
}
__device__ __forceinline__ void attn_c_ref(const bf16* proj, bf16* mixed, const float* rpb, int gw, int NGW, int lane) {
    for (int u = gw; u < M * 16; u += NGW) {
        const int t = u >> 4, h = u & 15; int T, sbase; seq_of(t, T, sbase); const int tl = t - sbase;
        const int R = tl >> 6, c = tl & 63, rows = T >> 6;
        int rs = R - 4; rs = rs < 0 ? 0 : rs; rs = rs > rows - 8 ? rows - 8 : rs;
        int cs = c - 8; cs = cs < 0 ? 0 : cs; cs = cs > 48 ? 48 : cs;
        float m = -1e30f, l = 0.f, o0 = 0.f, o1 = 0.f;
        const unsigned qw = ((const unsigned*)(proj + (size_t)t * NPROJ + h * 128))[lane];
        const float q0 = bf_lo(qw) * (SM_SCALE * LOG2E), q1 = bf_hi(qw) * (SM_SCALE * LOG2E);
        const float* rp = rpb + h * 15 * 31;
#pragma unroll 4
        for (int kk = 0; kk < 128; ++kk) {
            const int kr = rs + (kk >> 4), kc = cs + (kk & 15);
            const unsigned* kp = (const unsigned*)(proj + (size_t)(sbase + kr * 64 + kc) * NPROJ + 2048 + h * 128);
            const unsigned kw = kp[lane], vw = kp[1024 + lane];
            const float s = wave_sum(q0 * bf_lo(kw) + q1 * bf_hi(kw)) + rp[(kr - R + 7) * 31 + (kc - c + 15)] * LOG2E;
            ONLINE_STEP(s, vw);
        }
        const float inv = 1.0f / l;
        ((unsigned*)(mixed + (size_t)t * 2048 + h * 128))[lane] = pk2(o0 * inv, o1 * inv);
    }
}

typedef short bf16x8 __attribute__((ext_vector_type(8)));
typedef short s16x4 __attribute__((ext_vector_type(4)));
typedef float f32x16 __attribute__((ext_vector_type(16)));
typedef float f32x2v __attribute__((ext_vector_type(2)));
typedef __bf16 bf16x2v __attribute__((ext_vector_type(2)));
constexpr int ATT_TILE_BYTES = 8192;
constexpr int LUT_OFF = 129 * 1024 + 256;
constexpr float NEG_INF = -__builtin_inff(), DEFER_THR = 6.0f;
__device__ __forceinline__ unsigned off_a(unsigned row, unsigned ch) { return 2048u * (row >> 3) + 512u * (ch >> 2) + 64u * (row & 7) + 16u * ((ch & 3) ^ ((row >> 2) & 3)); }
__device__ __forceinline__ unsigned cvtpk(float lo, float hi) { f32x2v v = {lo, hi}; bf16x2v b = __builtin_convertvector(v, bf16x2v); return __builtin_bit_cast(unsigned, b); }
__device__ __forceinline__ s16x4 tr_read(const LAS unsigned char* p) { return __builtin_bit_cast(s16x4, __builtin_amdgcn_ds_read_tr16_b64_v4i16((LAS s16x4*)p)); }
__device__ __forceinline__ int crow16(int i) { return (i & 3) + 8 * (i >> 2); }

__device__ __forceinline__ void lut16(float (&b)[16], const LAS float* p) {
#pragma unroll
    for (int i = 0; i < 16; ++i) b[i] = p[crow16(i)];
    asm volatile("" : "+v"(b[0]), "+v"(b[1]), "+v"(b[2]), "+v"(b[3]), "+v"(b[4]), "+v"(b[5]), "+v"(b[6]), "+v"(b[7]), "+v"(b[8]), "+v"(b[9]), "+v"(b[10]), "+v"(b[11]), "+v"(b[12]), "+v"(b[13]), "+v"(b[14]), "+v"(b[15]));
}
struct AttnAcc { f32x16 o[4]; float m, l; };
__device__ __forceinline__ void tile_voff(unsigned (&voff)[8], int tstride, int lane) {
#pragma unroll
    for (int i = 0; i < 8; ++i) voff[i] = (unsigned)(((lane >> 4) + 4 * i) * tstride) * (unsigned)(NPROJ * 2) + 16u * (lane & 15);
}
__device__ __forceinline__ void tile_load(v4u (&r)[8], const bf16* base, int tok0, const unsigned (&voff)[8]) {
    const char* tb = (const char*)(base + (size_t)tok0 * NPROJ);
#pragma unroll
    for (int i = 0; i < 8; ++i) r[i] = *(const GAS v4u*)(tb + voff[i]);
}
__device__ __forceinline__ void tile_store(LAS unsigned char* t, const v4u (&r)[8], int lane) {
#pragma unroll
    for (int i = 0; i < 8; ++i) *(LAS v4u*)(t + off_a((lane >> 4) + 4 * i, lane & 15)) = r[i];
}
__device__ __forceinline__ f32x16 qk_tile(const LAS unsigned char* kt, const bf16x8 (&qf)[8], int lane, int rowoff = 0) {
    f32x16 st;
#pragma unroll
    for (int i = 0; i < 16; ++i) st[i] = 0.f;
    bf16x8 kf[8];
#pragma unroll
    for (int s = 0; s < 8; ++s) kf[s] = *(const LAS bf16x8*)(kt + off_a(rowoff + (lane & 31), 2 * s + (lane >> 5)));
    __builtin_amdgcn_sched_barrier(0);
#pragma unroll
    for (int s = 0; s < 8; ++s) st = __builtin_amdgcn_mfma_f32_32x32x16_bf16(kf[s], qf[s], st, 0, 0, 0);
    return st;
}
template <bool DEFER>
__device__ __forceinline__ void softmax_part(AttnAcc& A, f32x16 x, bf16x8 (&pb)[2], int lane) {
    float mx = x[0];
#pragma unroll
    for (int i = 1; i < 16; ++i) mx = fmaxf(mx, x[i]);
    mx = fmaxf(mx, __shfl_xor(mx, 32));
    if (!DEFER || __builtin_amdgcn_ballot_w64(mx > A.m + DEFER_THR) != 0ull) {
        const float mn = fmaxf(A.m, mx), alpha = __builtin_amdgcn_exp2f(A.m - mn); A.m = mn; A.l = A.l * alpha;
#pragma unroll
        for (int c = 0; c < 4; ++c) A.o[c] = A.o[c] * alpha;
    }
    const float mcur = A.m; float ps = 0.f;
#pragma unroll
    for (int i = 0; i < 16; ++i) { x[i] = __builtin_amdgcn_exp2f(x[i] - mcur); ps += x[i]; }
    A.l += ps;
#pragma unroll
    for (int ks = 0; ks < 2; ++ks) { v4u w; w.x = cvtpk(x[8 * ks], x[8 * ks + 1]); w.y = cvtpk(x[8 * ks + 2], x[8 * ks + 3]); w.z = cvtpk(x[8 * ks + 4], x[8 * ks + 5]); w.w = cvtpk(x[8 * ks + 6], x[8 * ks + 7]);
        pb[ks] = __builtin_bit_cast(bf16x8, w); }
}
__device__ __forceinline__ void pv_part(AttnAcc& A, const bf16x8 (&pb)[2], const LAS unsigned char* vt, int lane, int rowoff = 0) {
    const unsigned h = lane >> 5, blk = (lane >> 4) & 1, q = (lane & 15) >> 2, p = lane & 3;
    bf16x8 va[4][2];
#pragma unroll
    for (int c = 0; c < 4; ++c)
#pragma unroll
        for (int ks = 0; ks < 2; ++ks) {
            const s16x4 lo = tr_read(vt + off_a(rowoff + 16 * ks + 4 * h + q, 4 * c + 2 * blk + (p >> 1)) + 8 * (p & 1));
            const s16x4 hi = tr_read(vt + off_a(rowoff + 16 * ks + 8 + 4 * h + q, 4 * c + 2 * blk + (p >> 1)) + 8 * (p & 1));
            va[c][ks] = __builtin_shufflevector(lo, hi, 0, 1, 2, 3, 4, 5, 6, 7);
        }
    __builtin_amdgcn_sched_barrier(0);
#pragma unroll
    for (int c = 0; c < 4; ++c)
#pragma unroll
        for (int ks = 0; ks < 2; ++ks) A.o[c] = __builtin_amdgcn_mfma_f32_32x32x16_bf16(va[c][ks], pb[ks], A.o[c], 0, 0, 0);
}
template <bool DEFER>
__device__ __forceinline__ void softmax_pv(AttnAcc& A, f32x16 x, const LAS unsigned char* vt, int lane, int rowoff = 0) {
    bf16x8 pb[2]; softmax_part<DEFER>(A, x, pb, lane); pv_part(A, pb, vt, lane, rowoff);
}
__device__ __forceinline__ void acc_init(AttnAcc& A, float m0, float l0) {
#pragma unroll
    for (int c = 0; c < 4; ++c)
#pragma unroll
        for (int i = 0; i < 16; ++i) A.o[c][i] = 0.f;
    A.m = m0; A.l = l0;
}
__device__ __forceinline__ void q_load(bf16x8 (&qf)[8], const bf16* qrow, int lane) {
#pragma unroll
    for (int s = 0; s < 8; ++s) qf[s] = *(const GAS bf16x8*)(qrow + 16 * s + 8 * (lane >> 5));
}
__device__ __forceinline__ void o_store(const AttnAcc& A, float inv, bf16* orow, int lane) {
    const int h = lane >> 5;
#pragma unroll
    for (int c = 0; c < 4; ++c)
#pragma unroll
        for (int g = 0; g < 4; ++g) { v2u w; w.x = cvtpk(A.o[c][4 * g] * inv, A.o[c][4 * g + 1] * inv); w.y = cvtpk(A.o[c][4 * g + 2] * inv, A.o[c][4 * g + 3] * inv);
            *(GAS v2u*)(orow + 32 * c + 8 * g + 4 * h) = w; }
}
__device__ __forceinline__ void o_store_t(const AttnAcc& A, float inv, bf16* obase, int qtok, int pitch, LAS unsigned char* scr, int lane) {
    const int r = lane & 31, h = lane >> 5;
#pragma unroll
    for (int c = 0; c < 4; ++c)
#pragma unroll
        for (int g = 0; g < 4; ++g) { v2u w; w.x = cvtpk(A.o[c][4 * g] * inv, A.o[c][4 * g + 1] * inv); w.y = cvtpk(A.o[c][4 * g + 2] * inv, A.o[c][4 * g + 3] * inv);
            *(LAS v2u*)(scr + off_a(r, 4 * c + g) + 8 * h) = w; }
    asm volatile("s_waitcnt lgkmcnt(0)" ::: "memory");
#pragma unroll
    for (int i = 0; i < 8; ++i) { const int row = (lane >> 4) + 4 * i; const v4u v = *(const LAS v4u*)(scr + off_a(row, lane & 15)); const int tok = __shfl(qtok, row);
        *(GAS v4u*)(obase + (size_t)tok * pitch + 8 * (lane & 15)) = v; }
    asm volatile("s_waitcnt lgkmcnt(0)" ::: "memory");
}
__device__ __forceinline__ int virt_wave(int G, int wave) { const int bx = blockIdx.x; const int vb = (G % 8 == 0) ? (bx % 8) * (G / 8) + bx / 8 : bx; return vb * NWAVES + wave; }
__device__ __forceinline__ void seq_of_block(int gb, int& T, int& sbase, int& b) {
    if (gb < M_PROMPT / 32) { T = 4096; sbase = (gb >> 7) * 4096; b = gb & 127; } else { const int g2 = gb - M_PROMPT / 32; T = 8192; sbase = M_PROMPT + (g2 >> 8) * 8192; b = g2 & 255; }
}

__device__ __forceinline__ void attn_a_mfma(const bf16* proj, bf16* part, float* lse, LAS unsigned char* lds, int G, int wave, int lane) {
    LAS unsigned char* kt = lds + RING_OFF + wave * 16384; LAS unsigned char* vt = kt + ATT_TILE_BYTES;
    const LAS float* lut = (const LAS float*)(lds + LUT_OFF);
    constexpr int U = 12 * (M / 32); const int NGW = G * NWAVES, upw = (U + NGW - 1) / NGW, vw = virt_wave(G, wave);
    const int r = lane & 31, h = lane >> 5;
    for (int k = 0; k < upw; ++k) {
        const int u = k * NGW + vw; if (u >= U) break;
        const int gh = u / (M / 32), gb = u % (M / 32), g = gh >> 2, hs = gh & 3, sh = 2 * g;
        int T, sbase, b; seq_of_block(gb, T, sbase, b);
        const int l32 = (T >> 5) >> sh, rho = b / l32, p0 = 32 * (b % l32), L = 32 * l32, d = 1 << sh;
        const int qtok = sbase + rho + d * (p0 + r);
        bf16x8 qf[8]; q_load(qf, proj + (size_t)qtok * NPROJ + g * 1536 + hs * 128, lane);
        const bf16* kbase = proj + g * 1536 + 512 + hs * 128; const bf16* vbase = kbase + 512;
        const LAS float* lt = lut + (g * 4 + hs) * 129;
        AttnAcc A; acc_init(A, -1e30f, 0.f);
        int tt0 = 0, tt1 = 4;
        while (p0 - 64 + 32 * tt0 < 0) ++tt0;
        while (p0 - 64 + 32 * tt1 >= L) --tt1;
        v4u kr[8], vr[8]; unsigned voff[8]; tile_voff(voff, d, lane);
        tile_load(kr, kbase, sbase + rho + d * (p0 - 64 + 32 * tt0), voff); tile_load(vr, vbase, sbase + rho + d * (p0 - 64 + 32 * tt0), voff);
        for (int tt = tt0; tt <= tt1; ++tt) {
            tile_store(kt, kr, lane); tile_store(vt, vr, lane);
            if (tt < tt1) { const int nk = sbase + rho + d * (p0 - 64 + 32 * (tt + 1)); tile_load(kr, kbase, nk, voff); tile_load(vr, vbase, nk, voff); }
            f32x16 st = qk_tile(kt, qf, lane);
            const int ib = 32 * tt + 4 * h - r;
float bias[16]; lut16(bias, lt + ib);
#pragma unroll
            for (int i = 0; i < 16; ++i) { const int idx = ib + crow16(i); st[i] = ((unsigned)idx <= 128u) ? st[i] * (SM_SCALE * LOG2E) + bias[i] : NEG_INF; }
            softmax_pv<false>(A, st, vt, lane);
        }
        const float lt_ = A.l + __shfl_xor(A.l, 32), inv = 1.0f / lt_;
        o_store(A, inv, part + (size_t)qtok * D + g * 512 + hs * 128, lane);
        if (h == 0) lse[(size_t)qtok * 12 + g * 4 + hs] = A.m + __builtin_amdgcn_logf(lt_);
    }
}
struct MergeRegs { v4u a, b, c; float l0, l1, l2; };
__device__ __forceinline__ void merge_load(MergeRegs& R, const bf16* part, const float* lse, int t, int lane) {
    const int hs = lane >> 4;
    R.l0 = lse[(size_t)t * 12 + hs]; R.l1 = lse[(size_t)t * 12 + 4 + hs]; R.l2 = lse[(size_t)t * 12 + 8 + hs];
#if PART_HM
    int T, sbase; seq_of(t, T, sbase); const int tl = t - sbase, c8 = 8 * (lane & 15);
    const size_t r1 = (size_t)(sbase + (tl & 3) * (T >> 2) + (tl >> 2)), r2 = (size_t)(sbase + (tl & 15) * (T >> 4) + (tl >> 4));
    R.a = *(const GAS v4u*)(part + ((size_t)hs * M + t) * 128 + c8); R.b = *(const GAS v4u*)(part + ((size_t)(4 + hs) * M + r1) * 128 + c8); R.c = *(const GAS v4u*)(part + ((size_t)(8 + hs) * M + r2) * 128 + c8);
#else
    R.a = *(const GAS v4u*)(part + (size_t)t * D + 8 * lane); R.b = *(const GAS v4u*)(part + (size_t)t * D + 512 + 8 * lane); R.c = *(const GAS v4u*)(part + (size_t)t * D + 1024 + 8 * lane);
#endif
}
__device__ __forceinline__ void merge_store(const MergeRegs& R, bf16* mixed, int t, int lane) {
    const float mx = fmaxf(R.l0, fmaxf(R.l1, R.l2)); float w0 = __builtin_amdgcn_exp2f(R.l0 - mx), w1 = __builtin_amdgcn_exp2f(R.l1 - mx), w2 = __builtin_amdgcn_exp2f(R.l2 - mx);
    const float inv = 1.0f / (w0 + w1 + w2); w0 *= inv; w1 *= inv; w2 *= inv;
    v4u o;
#pragma unroll
    for (int j = 0; j < 4; ++j) o[j] = pk2(w0 * bf_lo(R.a[j]) + w1 * bf_lo(R.b[j]) + w2 * bf_lo(R.c[j]), w0 * bf_hi(R.a[j]) + w1 * bf_hi(R.b[j]) + w2 * bf_hi(R.c[j]));
    *(GAS v4u*)(mixed + (size_t)t * 1536 + 8 * lane) = o;
}
__device__ __forceinline__ void merge_a(const bf16* part, const float* lse, bf16* mixed, int gw, int NGW, int lane) {
    MergeRegs ra, rb;
    int t = gw;
    if (t < M) merge_load(ra, part, lse, t, lane);
    while (t < M) {
        const int t1 = t + NGW; if (t1 < M) merge_load(rb, part, lse, t1, lane);
        merge_store(ra, mixed, t, lane);
        if (t1 >= M) break;
        const int t2 = t1 + NGW; if (t2 < M) merge_load(ra, part, lse, t2, lane);
        merge_store(rb, mixed, t1, lane);
        t = t2;
    }
}
__device__ __forceinline__ void attn_b_mfma(const bf16* proj, bf16* mixed, const float* sink, LAS unsigned char* lds, int G, int wave, int lane) {
    LAS unsigned char* kt = lds + RING_OFF + wave * 16384; LAS unsigned char* vt = kt + ATT_TILE_BYTES;
    const LAS float* lut = (const LAS float*)(lds + LUT_OFF) + 12 * 129;
    constexpr int U = 8 * (M / 32); const int NGW = G * NWAVES, upw = (U + NGW - 1) / NGW, vw = virt_wave(G, wave);
    const int r = lane & 31, h = lane >> 5; unsigned voff[8]; tile_voff(voff, 1, lane);
    for (int k = 0; k < upw; ++k) {
        const int u = k * NGW + vw; if (u >= U) break;
        const int hq = u & 3, gb = (u >> 2) % (M / 32), kvh = (u >> 2) / (M / 32), hd = kvh * 4 + hq;
        int T, sbase, b; seq_of_block(gb, T, sbase, b);
        const int t0 = 32 * b, qtok = sbase + t0 + r;
        bf16x8 qf[8]; q_load(qf, proj + (size_t)qtok * NPROJ + 4608 + hd * 128, lane);
        const bf16* kbase = proj + 4608 + 1024 + kvh * 128; const bf16* vbase = kbase + 256;
        const LAS float* lt = lut + hd * 257;
        AttnAcc A; acc_init(A, sink[hd] * LOG2E, h == 0 ? 1.f : 0.f);
        int tt0 = 0, tt1 = 8;
        while (t0 - 128 + 32 * tt0 < 0) ++tt0;
        while (t0 - 128 + 32 * tt1 >= T) --tt1;
        v4u kr[8], vr[8];
        tile_load(kr, kbase, sbase + t0 - 128 + 32 * tt0, voff); tile_load(vr, vbase, sbase + t0 - 128 + 32 * tt0, voff);
        for (int tt = tt0; tt <= tt1; ++tt) {
            tile_store(kt, kr, lane); tile_store(vt, vr, lane);
            if (tt < tt1) { const int nk = sbase + t0 - 128 + 32 * (tt + 1); tile_load(kr, kbase, nk, voff); tile_load(vr, vbase, nk, voff); }
            f32x16 st = qk_tile(kt, qf, lane);
            const int ib = 32 * tt + 4 * h - r;
float bias[16]; lut16(bias, lt + ib);
#pragma unroll
            for (int i = 0; i < 16; ++i) { const int idx = ib + crow16(i); st[i] = ((unsigned)idx <= 256u) ? st[i] * (SM_SCALE * LOG2E) + bias[i] : NEG_INF; }
            softmax_pv<false>(A, st, vt, lane);
        }
        const float inv = 1.0f / (A.l + __shfl_xor(A.l, 32));
        o_store(A, inv, mixed + (size_t)qtok * 1536 + 512 + hd * 128, lane);
    }
}
__device__ __forceinline__ void attn_c_mfma(const bf16* proj, bf16* mixed, LAS unsigned char* lds, int G, int wave, int lane) {
    LAS unsigned char* kt = lds + RING_OFF + wave * 16384; LAS unsigned char* vt = kt + ATT_TILE_BYTES;
    const LAS float* lut = (const LAS float*)(lds + LUT_OFF);
    constexpr int U = 16 * (M / 32); const int NGW = G * NWAVES, upw = (U + NGW - 1) / NGW, vw = virt_wave(G, wave);
    const int r = lane & 31, h = lane >> 5; unsigned voff[8]; tile_voff(voff, 1, lane);
    for (int k = 0; k < upw; ++k) {
        const int u = k * NGW + vw; if (u >= U) break;
        const int hd = u / (M / 32), gbc = u % (M / 32), rp = gbc >> 2, c0 = 16 * (gbc & 3);
        int rows, sbase, R0;
        if (rp < 128) { rows = 64; sbase = (rp >> 5) * 4096; R0 = 2 * (rp & 31); } else { const int r2 = rp - 128; rows = 128; sbase = M_PROMPT + (r2 >> 6) * 8192; R0 = 2 * (r2 & 63); }
        const int Rq = R0 + (r >> 4), cq = c0 + (r & 15), qtok = sbase + Rq * 64 + cq;
        int rsq = Rq - 4; rsq = rsq < 0 ? 0 : (rsq > rows - 8 ? rows - 8 : rsq);
        int csq = cq - 8; csq = csq < 0 ? 0 : (csq > 48 ? 48 : csq);
        int rlo = R0 - 4; rlo = rlo < 0 ? 0 : (rlo > rows - 8 ? rows - 8 : rlo);
        int rhi = R0 - 3; rhi = (rhi < 0 ? 0 : (rhi > rows - 8 ? rows - 8 : rhi)) + 7;
        int kc0 = c0 - 8; kc0 = kc0 < 0 ? 0 : (kc0 > 32 ? 32 : kc0);
        bf16x8 qf[8]; q_load(qf, proj + (size_t)qtok * NPROJ + hd * 128, lane);
        const bf16* kbase = proj + 2048 + hd * 128; const bf16* vbase = kbase + 2048;
        const LAS float* lt = lut + hd * 465;
        AttnAcc A; acc_init(A, -1e30f, 0.f);
        v4u kr[8], vr[8];
        tile_load(kr, kbase, sbase + rlo * 64 + kc0, voff); tile_load(vr, vbase, sbase + rlo * 64 + kc0, voff);
        for (int krow = rlo; krow <= rhi; ++krow) {
            tile_store(kt, kr, lane); tile_store(vt, vr, lane);
            if (krow < rhi) { const int nk = sbase + (krow + 1) * 64 + kc0; tile_load(kr, kbase, nk, voff); tile_load(vr, vbase, nk, voff); }
            f32x16 st = qk_tile(kt, qf, lane);
            const bool rowok = (unsigned)(krow - rsq) < 8u;
            const int cb = kc0 + 4 * h - csq;
            const int ib = (krow - Rq + 7) * 31 + (kc0 + 4 * h - cq + 15);
float bias[16]; lut16(bias, lt + ib);
#pragma unroll
            for (int i = 0; i < 16; ++i) st[i] = (rowok && (unsigned)(cb + crow16(i)) < 16u) ? st[i] * (SM_SCALE * LOG2E) + bias[i] : NEG_INF;
            softmax_pv<false>(A, st, vt, lane);
        }
        const float inv = 1.0f / (A.l + __shfl_xor(A.l, 32));
        o_store(A, inv, mixed + (size_t)qtok * 2048 + hd * 128, lane);
    }
}
__device__ __forceinline__ void lut_fill_ab(const float* t5, LAS unsigned char* lds, int tid) {
    LAS float* lut = (LAS float*)(lds + LUT_OFF);
    for (int i = tid; i < 12 * 129; i += NWAVES * 64) { const int gh = i / 129, rel = i % 129 - 64, g = gh >> 2; lut[i] = t5[t5b(rel * (1 << (2 * g))) * 20 + gh] * LOG2E; }
    for (int i = tid; i < 8 * 257; i += NWAVES * 64) { const int hd = i / 257, rel = i % 257 - 128; lut[12 * 129 + i] = t5[t5b(rel) * 20 + 12 + hd] * LOG2E; }
}
__device__ __forceinline__ void lut_fill_c(const float* rpb, LAS unsigned char* lds, int tid) {
    LAS float* lut = (LAS float*)(lds + LUT_OFF);
    for (int i = tid; i < 16 * 465; i += NWAVES * 64) lut[i] = rpb[i] * LOG2E;
}

constexpr int WGT_BYTES = 16384;
__device__ __forceinline__ int virt_block(int G) { const int bx = blockIdx.x; return (G % 8 == 0) ? (bx % 8) * (G / 8) + bx / 8 : bx; }
__device__ __forceinline__ void seq_of_block256(int blk, int& T, int& sbase, int& b) {
    if (blk < M_PROMPT / 256) { T = 4096; sbase = (blk >> 4) * 4096; b = blk & 15; } else { const int g2 = blk - M_PROMPT / 256; T = 8192; sbase = M_PROMPT + (g2 >> 5) * 8192; b = g2 & 31; }
}
__device__ __forceinline__ void wg_tile_issue(v4u& kr, v4u& vr, const bf16* kbase, const bf16* vbase, int tok0, int tstride, int tid) {
    const size_t off = (size_t)(tok0 + (tid >> 4) * tstride) * PRS + 8 * (tid & 15);
    kr = *(const GAS v4u*)(kbase + off); vr = *(const GAS v4u*)(vbase + off);
}
__device__ __forceinline__ void wg_tile_commit(LAS unsigned char* buf, const v4u& kr, const v4u& vr, int tid) {
    const unsigned o = off_a(tid >> 4, tid & 15);
    *(LAS v4u*)(buf + o) = kr; *(LAS v4u*)(buf + ATT_TILE_BYTES + o) = vr;
}
#define WG_BAR() do { asm volatile("s_waitcnt lgkmcnt(0)" ::: "memory"); __builtin_amdgcn_s_barrier(); asm volatile("" ::: "memory"); } while (0)
template <class Geo>
__device__ __forceinline__ void wg_stream(const Geo& geo, const bf16* kbase, const bf16* vbase, int tstride, AttnAcc& A, const bf16x8 (&qf)[8], LAS unsigned char* tb, int lane, int tid) {
    const int j0 = geo.j0, j1 = geo.j1;
    v4u k0, v0, k1, v1, k2, v2;
    wg_tile_issue(k0, v0, kbase, vbase, geo.tok0(j0), tstride, tid);
    if (j0 + 1 <= j1) wg_tile_issue(k1, v1, kbase, vbase, geo.tok0(j0 + 1), tstride, tid);
    if (j0 + 2 <= j1) wg_tile_issue(k2, v2, kbase, vbase, geo.tok0(j0 + 2), tstride, tid);
    wg_tile_commit(tb + (j0 & 1) * WGT_BYTES, k0, v0, tid);
    WG_BAR();
#define WG_STEP(jj, KI, VI, KC, VC) do { \
        if ((jj) + 3 <= j1) wg_tile_issue(KI, VI, kbase, vbase, geo.tok0((jj) + 3), tstride, tid); \
        if (geo.active(jj)) { const LAS unsigned char* kt_ = tb + ((jj) & 1) * WGT_BYTES; f32x16 st_ = qk_tile(kt_, qf, lane); geo.logits(st_, (jj)); softmax_pv<true>(A, st_, kt_ + ATT_TILE_BYTES, lane); } \
        if ((jj) + 1 <= j1) wg_tile_commit(tb + (((jj) + 1) & 1) * WGT_BYTES, KC, VC, tid); \
        WG_BAR(); } while (0)
    for (int j = j0; j <= j1; j += 3) {
        WG_STEP(j, k0, v0, k1, v1);
        if (j + 1 > j1) break;
        WG_STEP(j + 1, k1, v1, k2, v2);
        if (j + 2 > j1) break;
        WG_STEP(j + 2, k2, v2, k0, v0);
    }
#undef WG_STEP
}
struct GeoA { int j0, j1, wave, tokb, d, ibw; const LAS float* lt;
    __device__ __forceinline__ int tok0(int j) const { return tokb + d * 32 * j; }
    __device__ __forceinline__ bool active(int j) const { return j >= wave && j <= wave + 4; }
    __device__ __forceinline__ void logits(f32x16& st, int j) const { const int ib = 32 * j + ibw;
float bias[16]; lut16(bias, lt + ib);
        if (j - wave >= 1 && j - wave <= 3) {
#pragma unroll
            for (int i = 0; i < 16; ++i) st[i] = st[i] * (SM_SCALE * LOG2E) + bias[i];
        } else {
#pragma unroll
            for (int i = 0; i < 16; ++i) { const int idx = ib + crow16(i); st[i] = ((unsigned)idx <= 128u) ? st[i] * (SM_SCALE * LOG2E) + bias[i] : NEG_INF; }
        } }
};
__device__ __forceinline__ void attn_a_wg(const bf16* proj, bf16* part, float* lse, LAS unsigned char* lds, int G, int wave, int lane, int tid) {
    LAS unsigned char* tb = lds + RING_OFF;
    const LAS float* lut = (const LAS float*)(lds + LUT_OFF);
    constexpr int U = 12 * (M / 256); const int vb = virt_block(G);
    const int r = lane & 31, h = lane >> 5;
    for (int k = 0; ; ++k) {
        const int u = k * G + vb; if (u >= U) break;
        const int gh = u / (M / 256), blk = u % (M / 256), g = gh >> 2, hs = gh & 3, sh = 2 * g, d = 1 << sh;
        int T, sbase, b; seq_of_block256(blk, T, sbase, b);
        const int l256 = (T >> 8) >> sh, rho = b / l256, P0 = 256 * (b % l256), L = 256 * l256;
        const int qtok = sbase + rho + d * (P0 + 32 * wave + r);
#if PROJ_HM
        const int qrow = sbase + rho * L + P0 + 32 * wave + r, ts = 1, tokb = sbase + rho * L + P0 - 64;
        bf16x8 qf[8]; q_load(qf, proj + PSLOT(g * 12 + hs) + (size_t)qrow * PRS, lane);
        const bf16* kbase = proj + PSLOT(g * 12 + 4 + hs); const bf16* vbase = kbase + PSLOT(4);
#else
        const int ts = d, tokb = sbase + rho + d * (P0 - 64);
        bf16x8 qf[8]; q_load(qf, proj + (size_t)qtok * NPROJ + g * 1536 + hs * 128, lane);
        const bf16* kbase = proj + g * 1536 + 512 + hs * 128; const bf16* vbase = kbase + 512;
#endif
        AttnAcc A; acc_init(A, -1e30f, 0.f);
        GeoA geo; geo.j0 = 0; geo.j1 = 11;
        while (P0 - 64 + 32 * geo.j0 < 0) ++geo.j0;
        while (P0 - 64 + 32 * geo.j1 >= L) --geo.j1;
        geo.wave = wave; geo.tokb = tokb; geo.d = ts; geo.ibw = 4 * h - r - 32 * wave; geo.lt = lut + (g * 4 + hs) * 129;
        wg_stream(geo, kbase, vbase, ts, A, qf, tb, lane, tid);
        const float lt_ = A.l + __shfl_xor(A.l, 32), inv = 1.0f / lt_;
#if PART_HM
        o_store_t(A, inv, part + (size_t)(g * 4 + hs) * ((size_t)M * 128), qrow, 128, lds + RING_OFF + 65536 + wave * 8192, lane);
#else
        o_store_t(A, inv, part + g * 512 + hs * 128, qtok, D, lds + RING_OFF + 65536 + wave * 8192, lane);
#endif
        if (h == 0) lse[(size_t)qtok * 12 + g * 4 + hs] = A.m + __builtin_amdgcn_logf(lt_);
    }
}
struct GeoB { int j0, j1, wave, tokb, ibw; const LAS float* lt;
    __device__ __forceinline__ int tok0(int j) const { return tokb + 32 * j; }
    __device__ __forceinline__ bool active(int j) const { return j >= wave && j <= wave + 8; }
    __device__ __forceinline__ void logits(f32x16& st, int j) const { const int ib = 32 * j + ibw;
float bias[16]; lut16(bias, lt + ib);
        if (j - wave >= 1 && j - wave <= 7) {
#pragma unroll
            for (int i = 0; i < 16; ++i) st[i] = st[i] * (SM_SCALE * LOG2E) + bias[i];
        } else {
#pragma unroll
            for (int i = 0; i < 16; ++i) { const int idx = ib + crow16(i); st[i] = ((unsigned)idx <= 256u) ? st[i] * (SM_SCALE * LOG2E) + bias[i] : NEG_INF; }
        } }
};
__device__ __forceinline__ void attn_b_wg(const bf16* proj, bf16* mixed, const float* sink, LAS unsigned char* lds, int G, int wave, int lane, int tid) {
    LAS unsigned char* tb = lds + RING_OFF;
    const LAS float* lut = (const LAS float*)(lds + LUT_OFF) + 12 * 129;
    constexpr int U = 8 * (M / 256); const int vb = virt_block(G);
    const int r = lane & 31, h = lane >> 5;
    for (int k = 0; ; ++k) {
        const int u = k * G + vb; if (u >= U) break;
        const int hq = u & 3, blk = (u >> 2) % (M / 256), kvh = (u >> 2) / (M / 256), hd = kvh * 4 + hq;
        int T, sbase, b; seq_of_block256(blk, T, sbase, b);
        const int t0 = 256 * b, qtok = sbase + t0 + 32 * wave + r;
        bf16x8 qf[8]; q_load(qf, proj + (size_t)qtok * NPROJ + 4608 + hd * 128, lane);
        const bf16* kbase = proj + 4608 + 1024 + kvh * 128; const bf16* vbase = kbase + 256;
        AttnAcc A; acc_init(A, sink[hd] * LOG2E, h == 0 ? 1.f : 0.f);
        GeoB geo; geo.j0 = 0; geo.j1 = 15;
        while (t0 - 128 + 32 * geo.j0 < 0) ++geo.j0;
        while (t0 - 128 + 32 * geo.j1 >= T) --geo.j1;
        geo.wave = wave; geo.tokb = sbase + t0 - 128; geo.ibw = 4 * h - r - 32 * wave; geo.lt = lut + hd * 257;
        wg_stream(geo, kbase, vbase, 1, A, qf, tb, lane, tid);
        const float inv = 1.0f / (A.l + __shfl_xor(A.l, 32));
        o_store(A, inv, mixed + (size_t)qtok * 1536 + 512 + hd * 128, lane);
    }
}
struct GeoB2 { int j0, j1, qt, tokb, ibw; const LAS float* lt;
    __device__ __forceinline__ int tok0(int j) const { return tokb + 32 * j; }
    __device__ __forceinline__ bool active(int j) const { return j >= qt && j <= qt + 8; }
    __device__ __forceinline__ void logits(f32x16& st, int j) const { const int ib = 32 * j + ibw;
        float bias[16]; lut16(bias, lt + ib);
        if (j - qt >= 1 && j - qt <= 7) {
#pragma unroll
            for (int i = 0; i < 16; ++i) st[i] = st[i] * (SM_SCALE * LOG2E) + bias[i];
        } else {
#pragma unroll
            for (int i = 0; i < 16; ++i) { const int idx = ib + crow16(i); st[i] = ((unsigned)idx <= 256u) ? st[i] * (SM_SCALE * LOG2E) + bias[i] : NEG_INF; }
        } }
};
__device__ __forceinline__ void attn_b_gqa(const bf16* proj, bf16* mixed, const float* sink, LAS unsigned char* lds, int G, int wave, int lane, int tid) {
    LAS unsigned char* tb = lds + RING_OFF;
    const LAS float* lut = (const LAS float*)(lds + LUT_OFF) + 12 * 129;
    constexpr int U = 2 * (M / 64); const int vb = virt_block(G);
    const int r = lane & 31, h = lane >> 5, hq = wave & 3, qt = wave >> 2;
    for (int k = 0; ; ++k) {
        const int u = k * G + vb; if (u >= U) break;
        const int kvh = u / (M / 64), blk64 = u % (M / 64), hd = kvh * 4 + hq;
        int T, sbase, b; seq_of_block256(blk64 >> 2, T, sbase, b);
        const int t0 = 256 * b + 64 * (blk64 & 3), qtok = sbase + t0 + 32 * qt + r;
        bf16x8 qf[8]; q_load(qf, proj + PSLOT(36 + hd) + (size_t)qtok * PRS, lane);
        const bf16* kbase = proj + PSLOT(44 + kvh); const bf16* vbase = kbase + PSLOT(2);
        AttnAcc A; acc_init(A, sink[hd] * LOG2E, h == 0 ? 1.f : 0.f);
        GeoB2 geo; geo.j0 = 0; geo.j1 = 9;
        while (t0 - 128 + 32 * geo.j0 < 0) ++geo.j0;
        while (t0 - 128 + 32 * geo.j1 >= T) --geo.j1;
        geo.qt = qt; geo.tokb = sbase + t0 - 128; geo.ibw = 4 * h - r - 32 * qt; geo.lt = lut + hd * 257;
        wg_stream(geo, kbase, vbase, 1, A, qf, tb, lane, tid);
        const float inv = 1.0f / (A.l + __shfl_xor(A.l, 32));
        o_store_t(A, inv, mixed + 512 + hd * 128, qtok, 1536, lds + RING_OFF + 65536 + wave * 8192, lane);
    }
}
struct GeoC { int j0, j1, cb, tokb, glo, wlo, whi, rsq, csq, Rq, cq, h; const LAS float* lt;
    __device__ __forceinline__ int tok0(int j) const { return tokb + 32 * j; }
    __device__ __forceinline__ bool active(int j) const { const int krow = glo + (j >> 1); return krow >= wlo && krow <= whi && ((j & 1) == 0 ? cb <= 2 : cb >= 1); }
    __device__ __forceinline__ void logits(f32x16& st, int j) const {
        const int krow = glo + (j >> 1), ch = j & 1; const bool rowok = (unsigned)(krow - rsq) < 8u;
        const int cbq = 32 * ch + 4 * h - csq;
        const int ib = (krow - Rq + 7) * 31 + (32 * ch + 4 * h - cq + 15);
float bias[16]; lut16(bias, lt + ib);
#pragma unroll
        for (int i = 0; i < 16; ++i) st[i] = (rowok && (unsigned)(cbq + crow16(i)) < 16u) ? st[i] * (SM_SCALE * LOG2E) + bias[i] : NEG_INF; }
};
__device__ __forceinline__ void attn_c_wg(const bf16* proj, bf16* mixed, LAS unsigned char* lds, int G, int wave, int lane, int tid) {
    LAS unsigned char* tb = lds + RING_OFF;
    const LAS float* lut = (const LAS float*)(lds + LUT_OFF);
    constexpr int U = 16 * (M / 256); const int vb = virt_block(G);
    const int r = lane & 31, h = lane >> 5, rp = wave >> 2, cb = wave & 3;
    for (int k = 0; ; ++k) {
        const int u = k * G + vb; if (u >= U) break;
        const int hd = u / (M / 256), blk = u % (M / 256);
        int T, sbase, b; seq_of_block256(blk, T, sbase, b);
        const int rows = T >> 6, R0 = 4 * b;
        const int Rq = R0 + 2 * rp + (r >> 4), cq = 16 * cb + (r & 15), qtok = sbase + Rq * 64 + cq;
        int rsq = Rq - 4; rsq = rsq < 0 ? 0 : (rsq > rows - 8 ? rows - 8 : rsq);
        int csq = cq - 8; csq = csq < 0 ? 0 : (csq > 48 ? 48 : csq);
        int wlo = R0 + 2 * rp - 4; wlo = wlo < 0 ? 0 : (wlo > rows - 8 ? rows - 8 : wlo);
        int whi = R0 + 2 * rp - 3; whi = (whi < 0 ? 0 : (whi > rows - 8 ? rows - 8 : whi)) + 7;
        int glo = R0 - 4; glo = glo < 0 ? 0 : (glo > rows - 8 ? rows - 8 : glo);
        int ghi = R0 - 1; ghi = (ghi < 0 ? 0 : (ghi > rows - 8 ? rows - 8 : ghi)) + 7;
        bf16x8 qf[8]; q_load(qf, proj + (size_t)qtok * NPROJ + hd * 128, lane);
        const bf16* kbase = proj + 2048 + hd * 128; const bf16* vbase = kbase + 2048;
        AttnAcc A; acc_init(A, -1e30f, 0.f);
        GeoC geo; geo.j0 = 0; geo.j1 = 2 * (ghi - glo + 1) - 1; geo.cb = cb; geo.tokb = sbase + glo * 64; geo.glo = glo; geo.wlo = wlo; geo.whi = whi;
        geo.rsq = rsq; geo.csq = csq; geo.Rq = Rq; geo.cq = cq; geo.h = h; geo.lt = lut + hd * 465;
        wg_stream(geo, kbase, vbase, 1, A, qf, tb, lane, tid);
        const float inv = 1.0f / (A.l + __shfl_xor(A.l, 32));
        o_store(A, inv, mixed + (size_t)qtok * 2048 + hd * 128, lane);
    }
}

constexpr int ROWT_BYTES = 32768, ROWK_BYTES = 16384;
struct RowRegs { v4u k[2], v[2]; };
__device__ __forceinline__ void row_issue(RowRegs& R, const bf16* kbase, const bf16* vbase, int tok0, int tid) {
#pragma unroll
    for (int i = 0; i < 2; ++i) { const int n = tid + 512 * i; const size_t off = (size_t)(tok0 + (n >> 4)) * PRS + 8 * (n & 15);
        R.k[i] = *(const GAS v4u*)(kbase + off); R.v[i] = *(const GAS v4u*)(vbase + off); }
}
__device__ __forceinline__ void row_commit(LAS unsigned char* buf, const RowRegs& R, int tid) {
#pragma unroll
    for (int i = 0; i < 2; ++i) { const int n = tid + 512 * i; const unsigned o = off_a(n >> 4, n & 15);
        *(LAS v4u*)(buf + o) = R.k[i]; *(LAS v4u*)(buf + ROWK_BYTES + o) = R.v[i]; }
}
__device__ __forceinline__ void attn_c_rows(const bf16* proj, bf16* mixed, LAS unsigned char* lds, int G, int wave, int lane, int tid) {
    LAS unsigned char* tb = lds + RING_OFF;
    const LAS float* lut = (const LAS float*)(lds + LUT_OFF);
    constexpr int U = 16 * (M / 256); const int vb = virt_block(G);
    const int r = lane & 31, h = lane >> 5, rp = wave >> 2, cbk = wave & 3;
    int kc0 = 16 * cbk - 8; kc0 = kc0 < 0 ? 0 : (kc0 > 32 ? 32 : kc0);
    for (int k = 0; ; ++k) {
        const int u = k * G + vb; if (u >= U) break;
#if C_RECENT
        const int third = u / (16 * 64), rem = u % (16 * 64), hd = rem >> 6, jj = rem & 63, blk = 24 * (jj >> 3) + (2 - third) * 8 + (jj & 7);
#else
        const int hd = u / (M / 256), blk = u % (M / 256);
#endif
        int T, sbase, b; seq_of_block256(blk, T, sbase, b);
        const int rows = T >> 6, R0 = 4 * b;
        const int Rq = R0 + 2 * rp + (r >> 4), cq = 16 * cbk + (r & 15), qtok = sbase + Rq * 64 + cq;
        int rsq = Rq - 4; rsq = rsq < 0 ? 0 : (rsq > rows - 8 ? rows - 8 : rsq);
        int csq = cq - 8; csq = csq < 0 ? 0 : (csq > 48 ? 48 : csq);
        int wlo = R0 + 2 * rp - 4; wlo = wlo < 0 ? 0 : (wlo > rows - 8 ? rows - 8 : wlo);
        int whi = R0 + 2 * rp - 3; whi = (whi < 0 ? 0 : (whi > rows - 8 ? rows - 8 : whi)) + 7;
        int glo = R0 - 4; glo = glo < 0 ? 0 : (glo > rows - 8 ? rows - 8 : glo);
        int ghi = R0 - 1; ghi = (ghi < 0 ? 0 : (ghi > rows - 8 ? rows - 8 : ghi)) + 7;
        bf16x8 qf[8]; q_load(qf, proj + PSLOT(hd) + (size_t)qtok * PRS, lane);
        const bf16* kbase = proj + PSLOT(16 + hd); const bf16* vbase = kbase + PSLOT(16);
        const LAS float* lt = lut + hd * 465;
        AttnAcc A; acc_init(A, -1e30f, 0.f);
        const int j1 = ghi - glo, tokb = sbase + glo * 64;
#define ROW_BODY(jj) do { \
        { const int krow_ = glo + (jj); \
          if (krow_ >= wlo && krow_ <= whi) { const LAS unsigned char* kt_ = tb + ((jj) & 1) * ROWT_BYTES; \
            f32x16 st_ = qk_tile(kt_, qf, lane, kc0); \
            const bool rowok_ = (unsigned)(krow_ - rsq) < 8u; const int cb_ = kc0 + 4 * h - csq; const int ib_ = (krow_ - Rq + 7) * 31 + (kc0 + 4 * h - cq + 15); \
            float bias_[16]; lut16(bias_, lt + ib_); \
            _Pragma("unroll") for (int i = 0; i < 16; ++i) st_[i] = (rowok_ && (unsigned)(cb_ + crow16(i)) < 16u) ? st_[i] * (SM_SCALE * LOG2E) + bias_[i] : NEG_INF; \
            softmax_pv<true>(A, st_, kt_ + ROWK_BYTES, lane, kc0); } } } while (0)
#if ATT_ROWS_PD == 3
        RowRegs r0, r1, r2;
        row_issue(r0, kbase, vbase, tokb, tid);
        if (1 <= j1) row_issue(r1, kbase, vbase, tokb + 64, tid);
        if (2 <= j1) row_issue(r2, kbase, vbase, tokb + 128, tid);
        row_commit(tb, r0, tid);
        WG_BAR();
#define ROW_STEP(jj, RI, RC) do { \
        if ((jj) + 3 <= j1) row_issue(RI, kbase, vbase, tokb + 64 * ((jj) + 3), tid); \
        ROW_BODY(jj); \
        if ((jj) + 1 <= j1) row_commit(tb + (((jj) + 1) & 1) * ROWT_BYTES, RC, tid); \
        WG_BAR(); } while (0)
        for (int j = 0; j <= j1; j += 3) {
            ROW_STEP(j, r0, r1);
            if (j + 1 > j1) break;
            ROW_STEP(j + 1, r1, r2);
            if (j + 2 > j1) break;
            ROW_STEP(j + 2, r2, r0);
        }
#else
        RowRegs r0, r1;
        row_issue(r0, kbase, vbase, tokb, tid);
        if (1 <= j1) row_issue(r1, kbase, vbase, tokb + 64, tid);
        row_commit(tb, r0, tid);
        WG_BAR();
#define ROW_STEP(jj, RI, RC) do { \
        if ((jj) + 2 <= j1) row_issue(RI, kbase, vbase, tokb + 64 * ((jj) + 2), tid); \
        ROW_BODY(jj); \
        if ((jj) + 1 <= j1) row_commit(tb + (((jj) + 1) & 1) * ROWT_BYTES, RC, tid); \
        WG_BAR(); } while (0)
        for (int j = 0; j <= j1; j += 2) {
            ROW_STEP(j, r0, r1);
            if (j + 1 > j1) break;
            ROW_STEP(j + 1, r1, r0);
        }
#endif
#undef ROW_STEP
#undef ROW_BODY
        const float inv = 1.0f / (A.l + __shfl_xor(A.l, 32));
        o_store_t(A, inv, mixed + hd * 128, qtok, 2048, lds + RING_OFF + 65536 + wave * 8192, lane);
    }
}

constexpr int A2S_BUF = 32768;
struct A2Regs { v4u k[2], v[2]; };
__device__ __forceinline__ void a2_issue(A2Regs& R, const bf16* kbase, int tok0, int tstride, int tid) {
    const size_t off = (size_t)(tok0 + (tid >> 4) * tstride) * NPROJ + 8 * (tid & 15);
    R.k[0] = *(const GAS v4u*)(kbase + off); R.v[0] = *(const GAS v4u*)(kbase + 512 + off); R.k[1] = *(const GAS v4u*)(kbase + 128 + off); R.v[1] = *(const GAS v4u*)(kbase + 640 + off);
}
__device__ __forceinline__ void a2_commit(LAS unsigned char* buf, const A2Regs& R, int tid) {
    const unsigned o = off_a(tid >> 4, tid & 15);
    *(LAS v4u*)(buf + o) = R.k[0]; *(LAS v4u*)(buf + ATT_TILE_BYTES + o) = R.v[0]; *(LAS v4u*)(buf + WGT_BYTES + o) = R.k[1]; *(LAS v4u*)(buf + WGT_BYTES + ATT_TILE_BYTES + o) = R.v[1];
}
__device__ __forceinline__ void attn_a_2s(const bf16* proj, bf16* part, float* lse, LAS unsigned char* lds, int G, int wave, int lane, int tid) {
    LAS unsigned char* tb = lds + RING_OFF;
    const LAS float* lut = (const LAS float*)(lds + LUT_OFF);
    constexpr int U = 6 * (M / 128); const int vb = virt_block(G);
    const int r = lane & 31, h = lane >> 5, sw = wave & 1, qt = wave >> 1;
    for (int k = 0; ; ++k) {
        const int u = k * G + vb; if (u >= U) break;
        const int ghp = u / (M / 128), blk = u % (M / 128), g = ghp >> 1, hp = ghp & 1, hs = 2 * hp + sw, sh = 2 * g, d = 1 << sh;
        int T, sbase, b256; seq_of_block256(blk >> 1, T, sbase, b256);
        const int b = 2 * b256 + (blk & 1);
        const int l128 = (T >> 7) >> sh, rho = b / l128, P0 = 128 * (b % l128), L = 128 * l128;
        const int qtok = sbase + rho + d * (P0 + 32 * qt + r);
        bf16x8 qf[8]; q_load(qf, proj + (size_t)qtok * NPROJ + g * 1536 + hs * 128, lane);
        const bf16* kbase = proj + g * 1536 + 512 + 2 * hp * 128;
        const LAS float* lt = lut + (g * 4 + hs) * 129;
        AttnAcc A; acc_init(A, -1e30f, 0.f);
        int j0 = 0, j1 = 7;
        while (P0 - 64 + 32 * j0 < 0) ++j0;
        while (P0 - 64 + 32 * j1 >= L) --j1;
        const int tokb = sbase + rho + d * (P0 - 64), ibw = 4 * h - r - 32 * qt;
        A2Regs r0, r1;
        a2_issue(r0, kbase, tokb + d * 32 * j0, d, tid);
        if (j0 + 1 <= j1) a2_issue(r1, kbase, tokb + d * 32 * (j0 + 1), d, tid);
        a2_commit(tb + (j0 & 1) * A2S_BUF, r0, tid);
        WG_BAR();
#define A2_STEP(jj, RI, RC) do { \
        if ((jj) + 2 <= j1) a2_issue(RI, kbase, tokb + d * 32 * ((jj) + 2), d, tid); \
        if ((jj) >= qt && (jj) <= qt + 4) { const LAS unsigned char* kt_ = tb + ((jj) & 1) * A2S_BUF + sw * WGT_BYTES; \
            f32x16 st_ = qk_tile(kt_, qf, lane); \
            const int ib_ = 32 * (jj) + ibw;                                         \
            float bias_[16]; lut16(bias_, lt + ib_); \
            _Pragma("unroll") for (int i = 0; i < 16; ++i) { const int idx_ = ib_ + crow16(i); st_[i] = ((unsigned)idx_ <= 128u) ? st_[i] * (SM_SCALE * LOG2E) + bias_[i] : NEG_INF; } \
            softmax_pv<true>(A, st_, kt_ + ATT_TILE_BYTES, lane); } \
        if ((jj) + 1 <= j1) a2_commit(tb + (((jj) + 1) & 1) * A2S_BUF, RC, tid); \
        WG_BAR(); } while (0)
        for (int j = j0; j <= j1; j += 2) {
            A2_STEP(j, r0, r1);
            if (j + 1 > j1) break;
            A2_STEP(j + 1, r1, r0);
        }
#undef A2_STEP
        const float lt_ = A.l + __shfl_xor(A.l, 32), inv = 1.0f / lt_;
        o_store_t(A, inv, part + g * 512 + hs * 128, qtok, D, lds + RING_OFF + 65536 + wave * 8192, lane);
        if (h == 0) lse[(size_t)qtok * 12 + g * 4 + hs] = A.m + __builtin_amdgcn_logf(lt_);
    }
}

#define DMA_WAIT(n) asm volatile("s_waitcnt vmcnt(" #n ")" ::: "memory")
#define LDS_DONE() asm volatile("s_waitcnt lgkmcnt(0)" ::: "memory")
__device__ __forceinline__ void dma_voff(unsigned (&voff)[8], int tstride, int lane) {
#pragma unroll
    for (int i = 0; i < 8; ++i) { const int row = 8 * (i >> 1) + ((lane >> 2) & 7), x = (2 * (i >> 1) + ((lane >> 4) & 1)) & 3, ch = 4 * (2 * (i & 1) + (lane >> 5)) + ((lane & 3) ^ x);
        voff[i] = (unsigned)(row * tstride) * (unsigned)(PRS * 2) + 16u * ch; }
}
__device__ __forceinline__ void tile_dma(LAS unsigned char* tile, const bf16* base, int tok0, const unsigned (&voff)[8]) {
    const char* tb = (const char*)(base + (size_t)tok0 * PRS);
#pragma unroll
    for (int i = 0; i < 8; ++i) __builtin_amdgcn_global_load_lds((const unsigned*)(tb + voff[i]), (LAS unsigned*)(tile + 1024 * i), 16, 0, 0);
}
__device__ __forceinline__ void attn_a_dma(const bf16* proj, bf16* part, float* lse, LAS unsigned char* lds, int G, int wave, int lane) {
    LAS unsigned char* kt = lds + RING_OFF + wave * 16384; LAS unsigned char* vt = kt + ATT_TILE_BYTES;
    const LAS float* lut = (const LAS float*)(lds + LUT_OFF);
    constexpr int U = 12 * (M / 32); const int NGW = G * NWAVES, upw = (U + NGW - 1) / NGW, vw = virt_wave(G, wave);
    const int r = lane & 31, h = lane >> 5;
    for (int k = 0; k < upw; ++k) {
        const int u = k * NGW + vw; if (u >= U) break;
        const int gh = u / (M / 32), gb = u % (M / 32), g = gh >> 2, hs = gh & 3, sh = 2 * g;
        int T, sbase, b; seq_of_block(gb, T, sbase, b);
        const int l32 = (T >> 5) >> sh, rho = b / l32, p0 = 32 * (b % l32), L = 32 * l32, d = 1 << sh;
        const int qtok = sbase + rho + d * (p0 + r);
#if PROJ_HM
        const int tb0 = sbase + rho * L + p0 - 64, ts = 1;
        bf16x8 qf[8]; q_load(qf, proj + PSLOT(g * 12 + hs) + (size_t)(tb0 + 64 + r) * PRS, lane);
        const bf16* kbase = proj + PSLOT(g * 12 + 4 + hs); const bf16* vbase = kbase + PSLOT(4);
#else
        const int tb0 = sbase + rho + d * (p0 - 64), ts = d;
        bf16x8 qf[8]; q_load(qf, proj + (size_t)qtok * NPROJ + g * 1536 + hs * 128, lane);
        const bf16* kbase = proj + g * 1536 + 512 + hs * 128; const bf16* vbase = kbase + 512;
#endif
        const LAS float* lt = lut + (g * 4 + hs) * 129;
        AttnAcc A; acc_init(A, -1e30f, 0.f);
        int tt0 = 0, tt1 = 4;
        while (p0 - 64 + 32 * tt0 < 0) ++tt0;
        while (p0 - 64 + 32 * tt1 >= L) --tt1;
        unsigned voff[8]; dma_voff(voff, ts, lane);
        LDS_DONE();
        tile_dma(kt, kbase, tb0 + ts * 32 * tt0, voff); tile_dma(vt, vbase, tb0 + ts * 32 * tt0, voff);
        for (int tt = tt0; tt <= tt1; ++tt) {
            const bool more = tt < tt1; const int nk = tb0 + ts * 32 * (tt + 1);
            DMA_WAIT(8);
            f32x16 st = qk_tile(kt, qf, lane);
            const int ib = 32 * tt + 4 * h - r;
            float bias[16]; lut16(bias, lt + ib);
            LDS_DONE();
            if (more) tile_dma(kt, kbase, nk, voff);
            if (tt >= 1 && tt <= 3) {
#pragma unroll
                for (int i = 0; i < 16; ++i) st[i] = st[i] * (SM_SCALE * LOG2E) + bias[i];
            } else {
#pragma unroll
                for (int i = 0; i < 16; ++i) { const int idx = ib + crow16(i); st[i] = ((unsigned)idx <= 128u) ? st[i] * (SM_SCALE * LOG2E) + bias[i] : NEG_INF; }
            }
            if (more) DMA_WAIT(8); else DMA_WAIT(0);
            softmax_pv<true>(A, st, vt, lane);
            LDS_DONE();
            if (more) tile_dma(vt, vbase, nk, voff);
        }
        const float lt_ = A.l + __shfl_xor(A.l, 32), inv = 1.0f / lt_;
#if PART_HM
        o_store_t(A, inv, part + (size_t)(g * 4 + hs) * ((size_t)M * 128), tb0 + 64 + r, 128, kt, lane);
#else
        o_store_t(A, inv, part + g * 512 + hs * 128, qtok, D, kt, lane);
#endif
        if (h == 0) lse[(size_t)qtok * 12 + g * 4 + hs] = A.m + __builtin_amdgcn_logf(lt_);
    }
}
#if PROJ_HM && PART_HM
struct AUnit { int g, hs, tb0, qtok0, d, tt0, tt1; };
__device__ __forceinline__ void a_decode(int u, AUnit& a) {
    const int gh = u / (M / 32), gb = u % (M / 32); a.g = gh >> 2; a.hs = gh & 3; const int sh = 2 * a.g;
    int T, sbase, b; seq_of_block(gb, T, sbase, b);
    const int l32 = (T >> 5) >> sh, rho = b / l32, p0 = 32 * (b % l32), L = 32 * l32; a.d = 1 << sh;
    a.tb0 = sbase + rho * L + p0 - 64; a.qtok0 = sbase + rho + a.d * p0;
    a.tt0 = 0; a.tt1 = 4;
    while (p0 - 64 + 32 * a.tt0 < 0) ++a.tt0;
    while (p0 - 64 + 32 * a.tt1 >= L) --a.tt1;
}
__device__ __forceinline__ void attn_a_xpf(const bf16* proj, bf16* part, float* lse, LAS unsigned char* lds, int G, int wave, int lane) {
    LAS unsigned char* kt = lds + RING_OFF + wave * 16384; LAS unsigned char* vt = kt + ATT_TILE_BYTES;
    const LAS float* lut = (const LAS float*)(lds + LUT_OFF);
    constexpr int U = 12 * (M / 32); const int NGW = G * NWAVES, vw = virt_wave(G, wave);
    const int r = lane & 31, h = lane >> 5;
    if (vw >= U) return;
    unsigned voff[8]; dma_voff(voff, 1, lane);
    AUnit cu; a_decode(vw, cu);
    bf16x8 qf[8]; q_load(qf, proj + PSLOT(cu.g * 12 + cu.hs) + (size_t)(cu.tb0 + 64 + r) * PRS, lane);
    LDS_DONE();
    tile_dma(kt, proj + PSLOT(cu.g * 12 + 4 + cu.hs), cu.tb0 + 32 * cu.tt0, voff); tile_dma(vt, proj + PSLOT(cu.g * 12 + 8 + cu.hs), cu.tb0 + 32 * cu.tt0, voff);
    for (int u = vw; u < U; u += NGW) {
        const bool has_next = u + NGW < U; AUnit nx = cu; if (has_next) a_decode(u + NGW, nx);
        const bf16* kbase = proj + PSLOT(cu.g * 12 + 4 + cu.hs); const bf16* vbase = kbase + PSLOT(4);
        const LAS float* lt = lut + (cu.g * 4 + cu.hs) * 129;
        AttnAcc A; acc_init(A, -1e30f, 0.f);
        for (int tt = cu.tt0; tt <= cu.tt1; ++tt) {
            const bool more = tt < cu.tt1; const int nk = cu.tb0 + 32 * (tt + 1);
            DMA_WAIT(8);
            f32x16 st = qk_tile(kt, qf, lane);
            const int ib = 32 * tt + 4 * h - r;
            float bias[16]; lut16(bias, lt + ib);
            LDS_DONE();
            if (more) tile_dma(kt, kbase, nk, voff);
            else if (has_next) tile_dma(kt, proj + PSLOT(nx.g * 12 + 4 + nx.hs), nx.tb0 + 32 * nx.tt0, voff);
            if (tt >= 1 && tt <= 3) {
#pragma unroll
                for (int i = 0; i < 16; ++i) st[i] = st[i] * (SM_SCALE * LOG2E) + bias[i];
            } else {
#pragma unroll
                for (int i = 0; i < 16; ++i) { const int idx = ib + crow16(i); st[i] = ((unsigned)idx <= 128u) ? st[i] * (SM_SCALE * LOG2E) + bias[i] : NEG_INF; }
            }
            if (more || has_next) DMA_WAIT(8); else DMA_WAIT(0);
            softmax_pv<true>(A, st, vt, lane);
            LDS_DONE();
            if (more) tile_dma(vt, vbase, nk, voff);
        }
        if (has_next) q_load(qf, proj + PSLOT(nx.g * 12 + nx.hs) + (size_t)(nx.tb0 + 64 + r) * PRS, lane);
        const float lt_ = A.l + __shfl_xor(A.l, 32), inv = 1.0f / lt_;
        o_store_t(A, inv, part + (size_t)(cu.g * 4 + cu.hs) * ((size_t)M * 128), cu.tb0 + 64 + r, 128, vt, lane);
        if (h == 0) lse[(size_t)(cu.qtok0 + cu.d * r) * 12 + cu.g * 4 + cu.hs] = A.m + __builtin_amdgcn_logf(lt_);
        if (has_next) tile_dma(vt, proj + PSLOT(nx.g * 12 + 8 + nx.hs), nx.tb0 + 32 * nx.tt0, voff);
        cu = nx;
    }
}
#endif
__device__ __forceinline__ void attn_c_dma(const bf16* proj, bf16* mixed, LAS unsigned char* lds, int G, int wave, int lane) {
    LAS unsigned char* kt = lds + RING_OFF + wave * 16384; LAS unsigned char* vt = kt + ATT_TILE_BYTES;
    const LAS float* lut = (const LAS float*)(lds + LUT_OFF);
    constexpr int U = 16 * (M / 32); const int NGW = G * NWAVES, upw = (U + NGW - 1) / NGW, vw = virt_wave(G, wave);
    const int r = lane & 31, h = lane >> 5; unsigned voff[8]; dma_voff(voff, 1, lane);
    for (int k = 0; k < upw; ++k) {
        const int u = k * NGW + vw; if (u >= U) break;
        const int hd = u / (M / 32), gbc = u % (M / 32), rp = gbc >> 2, c0 = 16 * (gbc & 3);
        int rows, sbase, R0;
        if (rp < 128) { rows = 64; sbase = (rp >> 5) * 4096; R0 = 2 * (rp & 31); } else { const int r2 = rp - 128; rows = 128; sbase = M_PROMPT + (r2 >> 6) * 8192; R0 = 2 * (r2 & 63); }
        const int Rq = R0 + (r >> 4), cq = c0 + (r & 15), qtok = sbase + Rq * 64 + cq;
        int rsq = Rq - 4; rsq = rsq < 0 ? 0 : (rsq > rows - 8 ? rows - 8 : rsq);
        int csq = cq - 8; csq = csq < 0 ? 0 : (csq > 48 ? 48 : csq);
        int rlo = R0 - 4; rlo = rlo < 0 ? 0 : (rlo > rows - 8 ? rows - 8 : rlo);
        int rhi = R0 - 3; rhi = (rhi < 0 ? 0 : (rhi > rows - 8 ? rows - 8 : rhi)) + 7;
        int kc0 = c0 - 8; kc0 = kc0 < 0 ? 0 : (kc0 > 32 ? 32 : kc0);
        bf16x8 qf[8]; q_load(qf, proj + (size_t)qtok * NPROJ + hd * 128, lane);
        const bf16* kbase = proj + 2048 + hd * 128; const bf16* vbase = kbase + 2048;
        const LAS float* lt = lut + hd * 465;
        AttnAcc A; acc_init(A, -1e30f, 0.f);
        LDS_DONE();
        tile_dma(kt, kbase, sbase + rlo * 64 + kc0, voff); tile_dma(vt, vbase, sbase + rlo * 64 + kc0, voff);
        for (int krow = rlo; krow <= rhi; ++krow) {
            const bool more = krow < rhi; const int nk = sbase + (krow + 1) * 64 + kc0;
            DMA_WAIT(8);
            f32x16 st = qk_tile(kt, qf, lane);
            const bool rowok = (unsigned)(krow - rsq) < 8u;
            const int cb = kc0 + 4 * h - csq;
            const int ib = (krow - Rq + 7) * 31 + (kc0 + 4 * h - cq + 15);
            float bias[16]; lut16(bias, lt + ib);
            LDS_DONE();
            if (more) tile_dma(kt, kbase, nk, voff);
#pragma unroll
            for (int i = 0; i < 16; ++i) st[i] = (rowok && (unsigned)(cb + crow16(i)) < 16u) ? st[i] * (SM_SCALE * LOG2E) + bias[i] : NEG_INF;
            if (more) DMA_WAIT(8); else DMA_WAIT(0);
            softmax_pv<true>(A, st, vt, lane);
            LDS_DONE();
            if (more) tile_dma(vt, vbase, nk, voff);
        }
        const float inv = 1.0f / (A.l + __shfl_xor(A.l, 32));
        o_store(A, inv, mixed + (size_t)qtok * 2048 + hd * 128, lane);
    }
}

#if ATT_A_WG == 2
#define ATTN_A(proj, part, lse, lds, G, wave, lane, tid) attn_a_2s(proj, part, lse, lds, G, wave, lane, tid)
#elif ATT_A_WG
#define ATTN_A(proj, part, lse, lds, G, wave, lane, tid) attn_a_wg(proj, part, lse, lds, G, wave, lane, tid)
#else
#if ATT_DMA && ATT_A_XPF && PROJ_HM && PART_HM
#define ATTN_A(proj, part, lse, lds, G, wave, lane, tid) attn_a_xpf(proj, part, lse, lds, G, wave, lane)
#elif ATT_DMA
#define ATTN_A(proj, part, lse, lds, G, wave, lane, tid) attn_a_dma(proj, part, lse, lds, G, wave, lane)
#else
#define ATTN_A(proj, part, lse, lds, G, wave, lane, tid) attn_a_mfma(proj, part, lse, lds, G, wave, lane)
#endif
#endif
#if ATT_B_WG
#define ATTN_B(proj, mixed, sink, lds, G, wave, lane, tid) attn_b_gqa(proj, mixed, sink, lds, G, wave, lane, tid)
#else
#define ATTN_B(proj, mixed, sink, lds, G, wave, lane, tid) attn_b_mfma(proj, mixed, sink, lds, G, wave, lane)
#endif
#if ATT_C_WG
#define ATTN_C(proj, mixed, lds, G, wave, lane, tid) attn_c_rows(proj, mixed, lds, G, wave, lane, tid)
#else
#if ATT_DMA
#define ATTN_C(proj, mixed, lds, G, wave, lane, tid) attn_c_dma(proj, mixed, lds, G, wave, lane)
#else
#define ATTN_C(proj, mixed, lds, G, wave, lane, tid) attn_c_mfma(proj, mixed, lds, G, wave, lane)
#endif
#endif

struct Args { const float* in[15]; float* out; unsigned char* ws; int ph_lo, ph_hi; };
static_assert(sizeof(Args) == 17 * 8 + 8, "Args has no holes");
template <bool FUSE_T>
__global__ void __launch_bounds__(NWAVES * 64, 2) enc_fwd(Args args) {
    extern __shared__ __attribute__((aligned(16))) unsigned char lds_raw[];
    LAS unsigned char* lds = (LAS unsigned char*)lds_raw;
    volatile LAS unsigned* MISC = (volatile LAS unsigned*)(lds + MISC_OFF);
    const int tid = threadIdx.x, lane = tid & 63, wave = __builtin_amdgcn_readfirstlane(tid >> 6);
    const int G = gridDim.x, gw = blockIdx.x * NWAVES + wave, NGW = G * NWAVES;
    unsigned char* ws = args.ws;
    gu32* ctl = (gu32*)(ws + WS_CTL);
    bf16* PART = (bf16*)args.out;
    bf16* XB = (bf16*)(ws + WS_XB); bf16* MIX = (bf16*)(ws + WS_MIX); bf16* PROJ = (bf16*)(ws + WS_PROJ);
    pg8::u64* SSQ = (pg8::u64*)(ws + WS_SSQ);
    for (int u = tid; u < (LDS_BYTES - LDSCTL_OFF) / 4; u += NWAVES * 64) ((LAS unsigned*)(lds + LDSCTL_OFF))[u] = 0u;
    __syncthreads();
    XcdBarrier bar; bar.bar = (unsigned*)(ctl + CW_BAR); bar.x = 0; bar.st = nullptr;
    if (!PER_PHASE_LAUNCH) bar = xcd_barrier_post((unsigned*)(ctl + CW_BAR), MISC + 8);
    const int lo = args.ph_lo, hi = args.ph_hi;
#define IN(k) (lo <= (k) && (k) < hi)
#define SEAM(k) do { if (!PER_PHASE_LAUNCH && IN(k) && IN((k) + 1)) xcd_barrier(bar); } while (0)
    LAS float* scr = (LAS float*)(lds + RING_OFF + wave * 16384);

    if (IN(0)) {
        prologue_rows(args.in[0], args.in[1], XB, SSQ, gw, NGW, lane);
        cvt_set(args.in, ws, 3, 0, 0, scr, gw, NGW, lane);
    }
    SEAM(0);
    { constexpr int L = 0;
        const int pb = 1 + 6 * L;
        const int ko = (L & 1) ? 2048 : 1536;
        if (IN(pb)) {
            pg8::Gemm g{XB, (const bf16*)(ws + WS_WIN), M, NPROJ, D}; pg8::StaticOrder S; S.init(M, NPROJ, G, (int)blockIdx.x, WGM_WIDE);
            pg8::EpiProj E{PROJ, NPROJ, SSQ + (size_t)(2 * L) * M, (L & 1) ? 0 : 3};
            if constexpr (NAP_L0 > 0 && L == 0) pg8::gemm_phase<pg8::EpiProj, pg8::StaticOrder, GEMM_ALIGN_EPI, GEMM_SP2, NAP_L0>(lds + RING_OFF, g, S, E);
            else
            pg8::gemm_phase<pg8::EpiProj, pg8::StaticOrder, GEMM_ALIGN_EPI, GEMM_SP2>(lds + RING_OFF, g, S, E);
        }
        SEAM(pb);
        if (IN(pb + 1)) {
            if (L & 1) lut_fill_c(args.in[7] + (size_t)(L >> 1) * 16 * 15 * 31, lds, tid); else lut_fill_ab(args.in[8], lds, tid);
#if !ATT_FIRST
            cvt_set(args.in, ws, (L + 1 < DEPTH ? 1 : 0) | (L >= 1 ? 2 : 0), L + 1 < DEPTH ? L + 1 : L, L, scr, gw, NGW, lane);
#endif
            __syncthreads();
            if (ATT_STATIC_PRIO && wave >= 4) __builtin_amdgcn_s_setprio(1);
            if (L & 1) ATTN_C(PROJ, MIX, lds, G, wave, lane, tid);
            else ATTN_A(PROJ, PART, (float*)(ws + WS_LSE), lds, G, wave, lane, tid);
            if (ATT_STATIC_PRIO) __builtin_amdgcn_s_setprio(0);
#if ATT_FIRST
            __syncthreads();
            cvt_set(args.in, ws, (L + 1 < DEPTH ? 1 : 0) | (L >= 1 ? 2 : 0), L + 1 < DEPTH ? L + 1 : L, L, scr, gw, NGW, lane);
#endif
        }
        SEAM(pb + 1);
        if (!(L & 1)) {
            if (IN(pb + 2)) {
                lut_fill_ab(args.in[8], lds, tid); __syncthreads();
                if (ATT_STATIC_PRIO && wave >= 4) __builtin_amdgcn_s_setprio(1);
                merge_a(PART, (const float*)(ws + WS_LSE), MIX, gw, NGW, lane);
                ATTN_B(PROJ, MIX, args.in[4] + (size_t)(L >> 1) * 8, lds, G, wave, lane, tid);
                if (ATT_STATIC_PRIO) __builtin_amdgcn_s_setprio(0);
            }
            SEAM(pb + 2);
        }
        if (IN(pb + 3)) {
            pg8::Gemm g{MIX, (const bf16*)(ws + WS_WOUT), M, D, ko}; pg8::StaticOrder S; S.init(M, D, G, (int)blockIdx.x, WGM_RES);
            pg8::EpiResid E{XB, SSQ + (size_t)(2 * L + 1) * M, D, 1.0f};
            pg8::gemm_phase<pg8::EpiResid, pg8::StaticOrder, GEMM_ALIGN_EPI, GEMM_SP2>(lds + RING_OFF, g, S, E);
        }
        SEAM(pb + 3);
        if (IN(pb + 4)) {
            pg8::Gemm g{XB, (const bf16*)(ws + WS_WGU), M, NGU, D}; pg8::StaticOrder S; S.init(M, NGU, G, (int)blockIdx.x, WGM_WIDE);
            pg8::EpiGateUp E{PROJ, FF, SSQ + (size_t)(2 * L + 1) * M};
            pg8::gemm_phase<pg8::EpiGateUp, pg8::StaticOrder, GEMM_ALIGN_EPI, GEMM_SP2>(lds + RING_OFF, g, S, E);
        }
        SEAM(pb + 4);
        if (IN(pb + 5)) {
            pg8::Gemm g{PROJ, (const bf16*)(ws + WS_WDN), M, D, FF}; pg8::StaticOrder S; S.init(M, D, G, (int)blockIdx.x, WGM_RES); S.rev = DOWN_REV;
            if constexpr (FUSE_T && L == DEPTH - 1) {
                pg8::EpiFinal E{XB, SSQ + (size_t)(2 * L + 2) * M, (unsigned*)(ctl + CW_FIN), args.in[14], args.out, D};
                pg8::gemm_phase<pg8::EpiFinal, pg8::StaticOrder, GEMM_ALIGN_EPI, GEMM_SP2>(lds + RING_OFF, g, S, E);
            } else {
            pg8::EpiResid E{XB, SSQ + (size_t)(2 * L + 2) * M, D, 1.0f};
            pg8::gemm_phase<pg8::EpiResid, pg8::StaticOrder, GEMM_ALIGN_EPI, GEMM_SP2>(lds + RING_OFF, g, S, E);
            }
        }
        if (!(FUSE_T && L == DEPTH - 1)) SEAM(pb + 5);
    }
    { constexpr int L = 1;
        const int pb = 1 + 6 * L;
        const int ko = (L & 1) ? 2048 : 1536;
        if (IN(pb)) {
            pg8::Gemm g{XB, (const bf16*)(ws + WS_WIN), M, NPROJ, D}; pg8::StaticOrder S; S.init(M, NPROJ, G, (int)blockIdx.x, WGM_WIDE);
            pg8::EpiProj E{PROJ, NPROJ, SSQ + (size_t)(2 * L) * M, (L & 1) ? 0 : 3};
            if constexpr (NAP_L0 > 0 && L == 0) pg8::gemm_phase<pg8::EpiProj, pg8::StaticOrder, GEMM_ALIGN_EPI, GEMM_SP2, NAP_L0>(lds + RING_OFF, g, S, E);
            else
            pg8::gemm_phase<pg8::EpiProj, pg8::StaticOrder, GEMM_ALIGN_EPI, GEMM_SP2>(lds + RING_OFF, g, S, E);
        }
        SEAM(pb);
        if (IN(pb + 1)) {
            if (L & 1) lut_fill_c(args.in[7] + (size_t)(L >> 1) * 16 * 15 * 31, lds, tid); else lut_fill_ab(args.in[8], lds, tid);
#if !ATT_FIRST
            cvt_set(args.in, ws, (L + 1 < DEPTH ? 1 : 0) | (L >= 1 ? 2 : 0), L + 1 < DEPTH ? L + 1 : L, L, scr, gw, NGW, lane);
#endif
            __syncthreads();
            if (ATT_STATIC_PRIO && wave >= 4) __builtin_amdgcn_s_setprio(1);
            if (L & 1) ATTN_C(PROJ, MIX, lds, G, wave, lane, tid);
            else ATTN_A(PROJ, PART, (float*)(ws + WS_LSE), lds, G, wave, lane, tid);
            if (ATT_STATIC_PRIO) __builtin_amdgcn_s_setprio(0);
#if ATT_FIRST
            __syncthreads();
            cvt_set(args.in, ws, (L + 1 < DEPTH ? 1 : 0) | (L >= 1 ? 2 : 0), L + 1 < DEPTH ? L + 1 : L, L, scr, gw, NGW, lane);
#endif
        }
        SEAM(pb + 1);
        if (!(L & 1)) {
            if (IN(pb + 2)) {
                lut_fill_ab(args.in[8], lds, tid); __syncthreads();
                if (ATT_STATIC_PRIO && wave >= 4) __builtin_amdgcn_s_setprio(1);
                merge_a(PART, (const float*)(ws + WS_LSE), MIX, gw, NGW, lane);
                ATTN_B(PROJ, MIX, args.in[4] + (size_t)(L >> 1) * 8, lds, G, wave, lane, tid);
                if (ATT_STATIC_PRIO) __builtin_amdgcn_s_setprio(0);
            }
            SEAM(pb + 2);
        }
        if (IN(pb + 3)) {
            pg8::Gemm g{MIX, (const bf16*)(ws + WS_WOUT), M, D, ko}; pg8::StaticOrder S; S.init(M, D, G, (int)blockIdx.x, WGM_RES);
            pg8::EpiResid E{XB, SSQ + (size_t)(2 * L + 1) * M, D, 1.0f};
            pg8::gemm_phase<pg8::EpiResid, pg8::StaticOrder, GEMM_ALIGN_EPI, GEMM_SP2>(lds + RING_OFF, g, S, E);
        }
        SEAM(pb + 3);
        if (IN(pb + 4)) {
            pg8::Gemm g{XB, (const bf16*)(ws + WS_WGU), M, NGU, D}; pg8::StaticOrder S; S.init(M, NGU, G, (int)blockIdx.x, WGM_WIDE);
            pg8::EpiGateUp E{PROJ, FF, SSQ + (size_t)(2 * L + 1) * M};
            pg8::gemm_phase<pg8::EpiGateUp, pg8::StaticOrder, GEMM_ALIGN_EPI, GEMM_SP2>(lds + RING_OFF, g, S, E);
        }
        SEAM(pb + 4);
        if (IN(pb + 5)) {
            pg8::Gemm g{PROJ, (const bf16*)(ws + WS_WDN), M, D, FF}; pg8::StaticOrder S; S.init(M, D, G, (int)blockIdx.x, WGM_RES); S.rev = DOWN_REV;
            if constexpr (FUSE_T && L == DEPTH - 1) {
                pg8::EpiFinal E{XB, SSQ + (size_t)(2 * L + 2) * M, (unsigned*)(ctl + CW_FIN), args.in[14], args.out, D};
                pg8::gemm_phase<pg8::EpiFinal, pg8::StaticOrder, GEMM_ALIGN_EPI, GEMM_SP2>(lds + RING_OFF, g, S, E);
            } else {
            pg8::EpiResid E{XB, SSQ + (size_t)(2 * L + 2) * M, D, 1.0f};
            pg8::gemm_phase<pg8::EpiResid, pg8::StaticOrder, GEMM_ALIGN_EPI, GEMM_SP2>(lds + RING_OFF, g, S, E);
            }
        }
        if (!(FUSE_T && L == DEPTH - 1)) SEAM(pb + 5);
    }
    { constexpr int L = 2;
        const int pb = 1 + 6 * L;
        const int ko = (L & 1) ? 2048 : 1536;
        if (IN(pb)) {
            pg8::Gemm g{XB, (const bf16*)(ws + WS_WIN), M, NPROJ, D}; pg8::StaticOrder S; S.init(M, NPROJ, G, (int)blockIdx.x, WGM_WIDE);
            pg8::EpiProj E{PROJ, NPROJ, SSQ + (size_t)(2 * L) * M, (L & 1) ? 0 : 3};
            if constexpr (NAP_L0 > 0 && L == 0) pg8::gemm_phase<pg8::EpiProj, pg8::StaticOrder, GEMM_ALIGN_EPI, GEMM_SP2, NAP_L0>(lds + RING_OFF, g, S, E);
            else
            pg8::gemm_phase<pg8::EpiProj, pg8::StaticOrder, GEMM_ALIGN_EPI, GEMM_SP2>(lds + RING_OFF, g, S, E);
        }
        SEAM(pb);
        if (IN(pb + 1)) {
            if (L & 1) lut_fill_c(args.in[7] + (size_t)(L >> 1) * 16 * 15 * 31, lds, tid); else lut_fill_ab(args.in[8], lds, tid);
#if !ATT_FIRST
            cvt_set(args.in, ws, (L + 1 < DEPTH ? 1 : 0) | (L >= 1 ? 2 : 0), L + 1 < DEPTH ? L + 1 : L, L, scr, gw, NGW, lane);
#endif
            __syncthreads();
            if (ATT_STATIC_PRIO && wave >= 4) __builtin_amdgcn_s_setprio(1);
            if (L & 1) ATTN_C(PROJ, MIX, lds, G, wave, lane, tid);
            else ATTN_A(PROJ, PART, (float*)(ws + WS_LSE), lds, G, wave, lane, tid);
            if (ATT_STATIC_PRIO) __builtin_amdgcn_s_setprio(0);
#if ATT_FIRST
            __syncthreads();
            cvt_set(args.in, ws, (L + 1 < DEPTH ? 1 : 0) | (L >= 1 ? 2 : 0), L + 1 < DEPTH ? L + 1 : L, L, scr, gw, NGW, lane);
#endif
        }
        SEAM(pb + 1);
        if (!(L & 1)) {
            if (IN(pb + 2)) {
                lut_fill_ab(args.in[8], lds, tid); __syncthreads();
                if (ATT_STATIC_PRIO && wave >= 4) __builtin_amdgcn_s_setprio(1);
                merge_a(PART, (const float*)(ws + WS_LSE), MIX, gw, NGW, lane);
                ATTN_B(PROJ, MIX, args.in[4] + (size_t)(L >> 1) * 8, lds, G, wave, lane, tid);
                if (ATT_STATIC_PRIO) __builtin_amdgcn_s_setprio(0);
            }
            SEAM(pb + 2);
        }
        if (IN(pb + 3)) {
            pg8::Gemm g{MIX, (const bf16*)(ws + WS_WOUT), M, D, ko}; pg8::StaticOrder S; S.init(M, D, G, (int)blockIdx.x, WGM_RES);
            pg8::EpiResid E{XB, SSQ + (size_t)(2 * L + 1) * M, D, 1.0f};
            pg8::gemm_phase<pg8::EpiResid, pg8::StaticOrder, GEMM_ALIGN_EPI, GEMM_SP2>(lds + RING_OFF, g, S, E);
        }
        SEAM(pb + 3);
        if (IN(pb + 4)) {
            pg8::Gemm g{XB, (const bf16*)(ws + WS_WGU), M, NGU, D}; pg8::StaticOrder S; S.init(M, NGU, G, (int)blockIdx.x, WGM_WIDE);
            pg8::EpiGateUp E{PROJ, FF, SSQ + (size_t)(2 * L + 1) * M};
            pg8::gemm_phase<pg8::EpiGateUp, pg8::StaticOrder, GEMM_ALIGN_EPI, GEMM_SP2>(lds + RING_OFF, g, S, E);
        }
        SEAM(pb + 4);
        if (IN(pb + 5)) {
            pg8::Gemm g{PROJ, (const bf16*)(ws + WS_WDN), M, D, FF}; pg8::StaticOrder S; S.init(M, D, G, (int)blockIdx.x, WGM_RES); S.rev = DOWN_REV;
            if constexpr (FUSE_T && L == DEPTH - 1) {
                pg8::EpiFinal E{XB, SSQ + (size_t)(2 * L + 2) * M, (unsigned*)(ctl + CW_FIN), args.in[14], args.out, D};
                pg8::gemm_phase<pg8::EpiFinal, pg8::StaticOrder, GEMM_ALIGN_EPI, GEMM_SP2>(lds + RING_OFF, g, S, E);
            } else {
            pg8::EpiResid E{XB, SSQ + (size_t)(2 * L + 2) * M, D, 1.0f};
            pg8::gemm_phase<pg8::EpiResid, pg8::StaticOrder, GEMM_ALIGN_EPI, GEMM_SP2>(lds + RING_OFF, g, S, E);
            }
        }
        if (!(FUSE_T && L == DEPTH - 1)) SEAM(pb + 5);
    }
    { constexpr int L = 3;
        const int pb = 1 + 6 * L;
        const int ko = (L & 1) ? 2048 : 1536;
        if (IN(pb)) {
            pg8::Gemm g{XB, (const bf16*)(ws + WS_WIN), M, NPROJ, D}; pg8::StaticOrder S; S.init(M, NPROJ, G, (int)blockIdx.x, WGM_WIDE);
            pg8::EpiProj E{PROJ, NPROJ, SSQ + (size_t)(2 * L) * M, (L & 1) ? 0 : 3};
            if constexpr (NAP_L0 > 0 && L == 0) pg8::gemm_phase<pg8::EpiProj, pg8::StaticOrder, GEMM_ALIGN_EPI, GEMM_SP2, NAP_L0>(lds + RING_OFF, g, S, E);
            else
            pg8::gemm_phase<pg8::EpiProj, pg8::StaticOrder, GEMM_ALIGN_EPI, GEMM_SP2>(lds + RING_OFF, g, S, E);
        }
        SEAM(pb);
        if (IN(pb + 1)) {
            if (L & 1) lut_fill_c(args.in[7] + (size_t)(L >> 1) * 16 * 15 * 31, lds, tid); else lut_fill_ab(args.in[8], lds, tid);
#if !ATT_FIRST
            cvt_set(args.in, ws, (L + 1 < DEPTH ? 1 : 0) | (L >= 1 ? 2 : 0), L + 1 < DEPTH ? L + 1 : L, L, scr, gw, NGW, lane);
#endif
            __syncthreads();
            if (ATT_STATIC_PRIO && wave >= 4) __builtin_amdgcn_s_setprio(1);
            if (L & 1) ATTN_C(PROJ, MIX, lds, G, wave, lane, tid);
            else ATTN_A(PROJ, PART, (float*)(ws + WS_LSE), lds, G, wave, lane, tid);
            if (ATT_STATIC_PRIO) __builtin_amdgcn_s_setprio(0);
#if ATT_FIRST
            __syncthreads();
            cvt_set(args.in, ws, (L + 1 < DEPTH ? 1 : 0) | (L >= 1 ? 2 : 0), L + 1 < DEPTH ? L + 1 : L, L, scr, gw, NGW, lane);
#endif
        }
        SEAM(pb + 1);
        if (!(L & 1)) {
            if (IN(pb + 2)) {
                lut_fill_ab(args.in[8], lds, tid); __syncthreads();
                if (ATT_STATIC_PRIO && wave >= 4) __builtin_amdgcn_s_setprio(1);
                merge_a(PART, (const float*)(ws + WS_LSE), MIX, gw, NGW, lane);
                ATTN_B(PROJ, MIX, args.in[4] + (size_t)(L >> 1) * 8, lds, G, wave, lane, tid);
                if (ATT_STATIC_PRIO) __builtin_amdgcn_s_setprio(0);
            }
            SEAM(pb + 2);
        }
        if (IN(pb + 3)) {
            pg8::Gemm g{MIX, (const bf16*)(ws + WS_WOUT), M, D, ko}; pg8::StaticOrder S; S.init(M, D, G, (int)blockIdx.x, WGM_RES);
            pg8::EpiResid E{XB, SSQ + (size_t)(2 * L + 1) * M, D, 1.0f};
            pg8::gemm_phase<pg8::EpiResid, pg8::StaticOrder, GEMM_ALIGN_EPI, GEMM_SP2>(lds + RING_OFF, g, S, E);
        }
        SEAM(pb + 3);
        if (IN(pb + 4)) {
            pg8::Gemm g{XB, (const bf16*)(ws + WS_WGU), M, NGU, D}; pg8::StaticOrder S; S.init(M, NGU, G, (int)blockIdx.x, WGM_WIDE);
            pg8::EpiGateUp E{PROJ, FF, SSQ + (size_t)(2 * L + 1) * M};
            pg8::gemm_phase<pg8::EpiGateUp, pg8::StaticOrder, GEMM_ALIGN_EPI, GEMM_SP2>(lds + RING_OFF, g, S, E);
        }
        SEAM(pb + 4);
        if (IN(pb + 5)) {
            pg8::Gemm g{PROJ, (const bf16*)(ws + WS_WDN), M, D, FF}; pg8::StaticOrder S; S.init(M, D, G, (int)blockIdx.x, WGM_RES); S.rev = DOWN_REV;
            if constexpr (FUSE_T && L == DEPTH - 1) {
                pg8::EpiFinal E{XB, SSQ + (size_t)(2 * L + 2) * M, (unsigned*)(ctl + CW_FIN), args.in[14], args.out, D};
                pg8::gemm_phase<pg8::EpiFinal, pg8::StaticOrder, GEMM_ALIGN_EPI, GEMM_SP2>(lds + RING_OFF, g, S, E);
            } else {
            pg8::EpiResid E{XB, SSQ + (size_t)(2 * L + 2) * M, D, 1.0f};
            pg8::gemm_phase<pg8::EpiResid, pg8::StaticOrder, GEMM_ALIGN_EPI, GEMM_SP2>(lds + RING_OFF, g, S, E);
            }
        }
        if (!(FUSE_T && L == DEPTH - 1)) SEAM(pb + 5);
    }
    if (!FUSE_T && IN(N_PHASES - 1)) {
        final_norm(args.out, XB, SSQ + (size_t)8 * M, args.in[14], gw, NGW, lane);
    }
#undef IN
#undef SEAM
}

extern "C" void kernel_launch(void* const* d_in, const int* in_sizes, int n_in, void* d_out, int out_size, void* d_ws, size_t ws_size, hipStream_t stream) {
    static int grid = 0; static bool fuse = false;
    if (grid == 0) {
        if (n_in != 15 || in_sizes[0] != M_PROMPT * D || in_sizes[1] != M_SAMPLE * D || out_size != M * D || ws_size < WS_END) {
            fprintf(stderr, "kernel_launch: unexpected shapes / workspace (n_in %d, out %d, ws %zu, need %zu); nothing launched\n", n_in, out_size, ws_size, (size_t)WS_END); grid = -1; return; }
        int dev = 0, cus = 0, per_cu = 0;
        if (hipGetDevice(&dev) != hipSuccess || hipDeviceGetAttribute(&cus, hipDeviceAttributeMultiprocessorCount, dev) != hipSuccess) { fprintf(stderr, "kernel_launch: device query failed\n"); grid = -1; return; }
        fuse = FUSE_FINAL && cus >= 249;
        const void* kf = fuse ? (const void*)enc_fwd<true> : (const void*)enc_fwd<false>;
        if (hipFuncSetAttribute(kf, hipFuncAttributeMaxDynamicSharedMemorySize, LDS_BYTES) != hipSuccess) { fprintf(stderr, "kernel_launch: hipFuncSetAttribute failed\n"); grid = -1; return; }
        if (hipOccupancyMaxActiveBlocksPerMultiprocessor(&per_cu, kf, NWAVES * 64, LDS_BYTES) != hipSuccess || per_cu < 1) {
            fprintf(stderr, "kernel_launch: occupancy query reports %d workgroups per CU; nothing launched\n", per_cu); (void)hipGetLastError(); grid = -1; return; }
        grid = cus;
    }
    if (grid < 0) return;
    if (hipMemsetAsync((char*)d_ws + WS_CTL, 0, CTL_ZERO_BYTES, stream) != hipSuccess) { fprintf(stderr, "kernel_launch: hipMemsetAsync failed\n"); return; }
    Args a{};
    for (int i = 0; i < 15; ++i) a.in[i] = (const float*)d_in[i];
    a.out = (float*)d_out; a.ws = (unsigned char*)d_ws;
    if (PER_PHASE_LAUNCH) {
        for (int p = 0; p < N_PHASES; ++p) { a.ph_lo = p; a.ph_hi = p + 1; hipLaunchKernelGGL(enc_fwd<false>, dim3(grid), dim3(NWAVES * 64), LDS_BYTES, stream, a); }
    } else {
        a.ph_lo = 0; a.ph_hi = N_PHASES;
        if (fuse) hipLaunchKernelGGL(enc_fwd<true>, dim3(grid), dim3(NWAVES * 64), LDS_BYTES, stream, a);
        else hipLaunchKernelGGL(enc_fwd<false>, dim3(grid), dim3(NWAVES * 64), LDS_BYTES, stream, a);
    }
    const hipError_t le = hipPeekAtLastError();
    if (le != hipSuccess) fprintf(stderr, "kernel_launch: launch failed: %s\n", hipGetErrorName(le));
}
```
